# Optimizing an MI355X kernel written in HIP

```python
import math
import jax, jax.numpy as jnp
from jax import lax
import numpy as np

D_MODEL = 1024
BATCH = 8
SEQ = 2048
DEPTH = 4
DEC_BATCH = 128
DEC_SEQ = 8
PAST_LEN = 8192
PAGE_SIZE = 128

N_MIXERS = 2
N_SSM_LAYERS = (DEPTH + 1) // 2
N_SWA_LAYERS = DEPTH // 2
SSM_GROUP = 16
N_GROUPS = D_MODEL // SSM_GROUP
STATE_DIM = 64
SCAN_CHUNK = 128
HEAD_DIM = 64
N_HEADS = D_MODEL // HEAD_DIM
N_KV_HEADS = 4
KV_REP = N_HEADS // N_KV_HEADS
WINDOW = 128
ATTN_BLOCK = WINDOW
ROT_DIM = HEAD_DIM // 4
ROPE_THETA = 500000.0
ATTN_SCALE = HEAD_DIM ** -0.5
D_FF = ((8 * D_MODEL + 3 * 256 - 1) // (3 * 256)) * 256
NORM_EPS = 1e-6
NEG_INF = -1e30

kernel_name = "hybrid_s5_swa_sink_decoder_step"


def rms_norm(x, g):
    xf = x.astype(jnp.float32)
    y = xf * lax.rsqrt(jnp.mean(xf * xf, axis=-1, keepdims=True) + NORM_EPS)
    return (y * g.astype(jnp.float32)).astype(x.dtype)


def rotary(x, pos):
    half = ROT_DIM // 2
    inv_freq = ROPE_THETA ** (-jnp.arange(half, dtype=jnp.float32) * 2.0 / ROT_DIM)
    ang = pos[:, None] * inv_freq[None, :]
    cos = jnp.cos(ang)[:, None, :]
    sin = jnp.sin(ang)[:, None, :]
    xf = x.astype(jnp.float32)
    x1 = xf[..., :half]
    x2 = xf[..., half:ROT_DIM]
    out = jnp.concatenate([x1 * cos - x2 * sin, x2 * cos + x1 * sin, xf[..., ROT_DIM:]], axis=-1)
    return out.astype(x.dtype)


def cmul(ar, ai, br, bi):
    return ar * br - ai * bi, ar * bi + ai * br


def ssm_discretize(a_re, a_im, log_dt, b_re, b_im):
    f32 = jnp.float32
    a_re = a_re.astype(f32)
    a_im = a_im.astype(f32)
    dt = jnp.exp(log_dt.astype(f32))[:, None]
    mag = jnp.exp(a_re * dt)
    lam_re = mag * jnp.cos(a_im * dt)
    lam_im = mag * jnp.sin(a_im * dt)
    den = a_re * a_re + a_im * a_im
    nr = lam_re - 1.0
    ni = lam_im
    f_re = (nr * a_re + ni * a_im) / den
    f_im = (ni * a_re - nr * a_im) / den
    b_re = b_re.astype(f32)
    b_im = b_im.astype(f32)
    bb_re = f_re[..., None] * b_re - f_im[..., None] * b_im
    bb_im = f_re[..., None] * b_im + f_im[..., None] * b_re
    return lam_re, lam_im, bb_re, bb_im


def ssm_combine(e1, e2):
    a1r, a1i, b1r, b1i = e1
    a2r, a2i, b2r, b2i = e2
    ar, ai = cmul(a1r, a1i, a2r, a2i)
    br, bi = cmul(a2r, a2i, b1r, b1i)
    return ar, ai, br + b2r, bi + b2i


def s5_mixer(x_n, h0_re, h0_im, a_re, a_im, log_dt, b_re, b_im, c_re, c_im, d, w_glu):
    f32 = jnp.float32
    bsz, seq_len, _ = x_n.shape
    lam_re, lam_im, bb_re, bb_im = ssm_discretize(a_re, a_im, log_dt, b_re, b_im)
    c_re = c_re.astype(f32)
    c_im = c_im.astype(f32)
    d_g = d.astype(f32).reshape(N_GROUPS, SSM_GROUP)
    t_blk = SCAN_CHUNK if seq_len % SCAN_CHUNK == 0 else seq_len
    n_blk = seq_len // t_blk
    u = x_n.astype(f32).reshape(bsz, n_blk, t_blk, N_GROUPS, SSM_GROUP).swapaxes(0, 1)

    def block_step(h, u_c):
        hr, hi = h
        br = jnp.einsum('btgc,gpc->btgp', u_c, bb_re)
        bi = jnp.einsum('btgc,gpc->btgp', u_c, bb_im)
        ir, ii = cmul(lam_re, lam_im, hr, hi)
        br = br.at[:, 0].add(ir)
        bi = bi.at[:, 0].add(ii)
        ar = jnp.broadcast_to(lam_re, br.shape)
        ai = jnp.broadcast_to(lam_im, bi.shape)
        _, _, hs_re, hs_im = lax.associative_scan(ssm_combine, (ar, ai, br, bi), axis=1)
        y = (jnp.einsum('btgp,gcp->btgc', hs_re, c_re)
             - jnp.einsum('btgp,gcp->btgc', hs_im, c_im)) + d_g * u_c
        return (hs_re[:, -1], hs_im[:, -1]), y

    (hr, hi), ys = lax.scan(block_step, (h0_re.astype(f32), h0_im.astype(f32)), u)
    y = ys.swapaxes(0, 1).reshape(bsz, seq_len, D_MODEL)
    z = jax.nn.gelu(y).astype(x_n.dtype)
    g = z @ w_glu
    out = g[..., :D_MODEL] * jax.nn.sigmoid(g[..., D_MODEL:])
    return out.astype(x_n.dtype), hr, hi


def qkv_project(x_n, w_qkv, q_gain, k_gain, pos):
    bsz, seq_len, _ = x_n.shape
    qkv = x_n @ w_qkv
    nq = N_HEADS * HEAD_DIM
    nk = N_KV_HEADS * HEAD_DIM
    q = qkv[..., :nq].reshape(bsz, seq_len, N_HEADS, HEAD_DIM)
    k = qkv[..., nq:nq + nk].reshape(bsz, seq_len, N_KV_HEADS, HEAD_DIM)
    v = qkv[..., nq + nk:].reshape(bsz, seq_len, N_KV_HEADS, HEAD_DIM)
    q = rotary(rms_norm(q, q_gain), pos)
    k = rotary(rms_norm(k, k_gain), pos)
    return q, k, v


def sink_softmax(scores, mask, sinks):
    s = jnp.where(mask, scores, NEG_INF)
    sk = sinks.astype(jnp.float32).reshape(N_KV_HEADS, KV_REP, 1, 1)
    m = jnp.maximum(jnp.max(s, axis=-1, keepdims=True), sk)
    p = jnp.exp(s - m)
    denom = jnp.sum(p, axis=-1, keepdims=True) + jnp.exp(sk - m)
    return p / denom


def swa_prompt(x_n, w_qkv, q_gain, k_gain, sinks, w_o):
    f32 = jnp.float32
    bsz, seq_len, _ = x_n.shape
    pos = jnp.arange(seq_len, dtype=f32)
    q, k, v = qkv_project(x_n, w_qkv, q_gain, k_gain, pos)
    nb = seq_len // ATTN_BLOCK
    qb = q.reshape(bsz, nb, ATTN_BLOCK, N_KV_HEADS, KV_REP, HEAD_DIM).astype(f32)
    kb = k.reshape(bsz, nb, ATTN_BLOCK, N_KV_HEADS, HEAD_DIM).astype(f32)
    vb = v.reshape(bsz, nb, ATTN_BLOCK, N_KV_HEADS, HEAD_DIM).astype(f32)
    kc = jnp.concatenate([jnp.concatenate([jnp.zeros_like(kb[:, :1]), kb[:, :-1]], axis=1), kb], axis=2)
    vc = jnp.concatenate([jnp.concatenate([jnp.zeros_like(vb[:, :1]), vb[:, :-1]], axis=1), vb], axis=2)
    scores = jnp.einsum('bnqkrd,bnskd->bnkrqs', qb, kc) * ATTN_SCALE
    iq = jnp.arange(ATTN_BLOCK)[:, None]
    js = jnp.arange(2 * ATTN_BLOCK)[None, :]
    diff = ATTN_BLOCK + iq - js
    blk = jnp.arange(nb)[:, None, None]
    mask = (diff >= 0) & (diff < WINDOW) & ((blk - 1) * ATTN_BLOCK + js >= 0)
    p = sink_softmax(scores, mask[None, :, None, None], sinks)
    o = jnp.einsum('bnkrqs,bnskd->bnqkrd', p, vc).reshape(bsz, seq_len, N_HEADS * HEAD_DIM)
    out = o.astype(x_n.dtype) @ w_o
    buf = min(WINDOW, seq_len)
    return out, k[:, seq_len - buf:], v[:, seq_len - buf:]


def swa_sample(x_n, cache_k, cache_v, w_qkv, q_gain, k_gain, sinks, w_o):
    f32 = jnp.float32
    bsz, s_len, _ = x_n.shape
    w_buf = cache_k.shape[1]
    pos = PAST_LEN + jnp.arange(s_len, dtype=f32)
    q, k, v = qkv_project(x_n, w_qkv, q_gain, k_gain, pos)
    k_all = jnp.concatenate([cache_k.astype(k.dtype), k], axis=1)
    v_all = jnp.concatenate([cache_v.astype(v.dtype), v], axis=1)
    kpos = PAST_LEN - w_buf + jnp.arange(w_buf + s_len)
    qpos = PAST_LEN + jnp.arange(s_len)
    diff = qpos[:, None] - kpos[None, :]
    mask = (diff >= 0) & (diff < WINDOW)
    qg = q.reshape(bsz, s_len, N_KV_HEADS, KV_REP, HEAD_DIM).astype(f32)
    scores = jnp.einsum('bqkrd,bskd->bkrqs', qg, k_all.astype(f32)) * ATTN_SCALE
    p = sink_softmax(scores, mask, sinks)
    o = jnp.einsum('bkrqs,bskd->bqkrd', p, v_all.astype(f32)).reshape(bsz, s_len, N_HEADS * HEAD_DIM)
    out = o.astype(x_n.dtype) @ w_o
    return out, k_all[:, -w_buf:], v_all[:, -w_buf:]


def swiglu(x_n, w_gate_up, w_down):
    h = x_n @ w_gate_up
    return (jax.nn.silu(h[..., :D_FF]) * h[..., D_FF:]) @ w_down


def setup_inputs(seed: int = 0) -> dict:
    key = jax.random.key(seed)
    ks = jax.random.split(key, 24)
    f32 = jnp.float32
    nrm = lambda k, shape, s=1.0: (jax.random.normal(k, shape, f32) * s)
    w_buf = min(WINDOW, PAST_LEN)
    a_im_base = jnp.pi * jnp.arange(STATE_DIM, dtype=f32)
    return {
        "x_prompt": nrm(ks[0], (BATCH, SEQ, D_MODEL)),
        "x_sample": nrm(ks[1], (DEC_BATCH, DEC_SEQ, D_MODEL)),
        "state_ssm_re": nrm(ks[2], (N_SSM_LAYERS, DEC_BATCH, N_GROUPS, STATE_DIM), 0.3),
        "state_ssm_im": nrm(ks[3], (N_SSM_LAYERS, DEC_BATCH, N_GROUPS, STATE_DIM), 0.3),
        "cache_swa_k": nrm(ks[4], (N_SWA_LAYERS, DEC_BATCH, w_buf, N_KV_HEADS, HEAD_DIM)),
        "cache_swa_v": nrm(ks[5], (N_SWA_LAYERS, DEC_BATCH, w_buf, N_KV_HEADS, HEAD_DIM)),
        "norm_mix": 1.0 + nrm(ks[6], (DEPTH, D_MODEL), 0.02),
        "norm_ffn": 1.0 + nrm(ks[7], (DEPTH, D_MODEL), 0.02),
        "ssm_a_re": -0.5 + nrm(ks[8], (N_SSM_LAYERS, N_GROUPS, STATE_DIM), 0.01),
        "ssm_a_im": a_im_base + nrm(ks[9], (N_SSM_LAYERS, N_GROUPS, STATE_DIM), 0.01),
        "ssm_log_dt": jax.random.uniform(ks[10], (N_SSM_LAYERS, N_GROUPS), f32, math.log(1e-3), math.log(1e-1)),
        "ssm_b_re": nrm(ks[11], (N_SSM_LAYERS, N_GROUPS, STATE_DIM, SSM_GROUP), (2 * SSM_GROUP) ** -0.5),
        "ssm_b_im": nrm(ks[12], (N_SSM_LAYERS, N_GROUPS, STATE_DIM, SSM_GROUP), (2 * SSM_GROUP) ** -0.5),
        "ssm_c_re": nrm(ks[13], (N_SSM_LAYERS, N_GROUPS, SSM_GROUP, STATE_DIM), STATE_DIM ** -0.5),
        "ssm_c_im": nrm(ks[14], (N_SSM_LAYERS, N_GROUPS, SSM_GROUP, STATE_DIM), STATE_DIM ** -0.5),
        "ssm_d": nrm(ks[15], (N_SSM_LAYERS, D_MODEL)),
        "ssm_w_glu": nrm(ks[16], (N_SSM_LAYERS, D_MODEL, 2 * D_MODEL), D_MODEL ** -0.5),
        "attn_w_qkv": nrm(ks[17], (N_SWA_LAYERS, D_MODEL, (N_HEADS + 2 * N_KV_HEADS) * HEAD_DIM), D_MODEL ** -0.5),
        "attn_q_norm": 1.0 + nrm(ks[18], (N_SWA_LAYERS, HEAD_DIM), 0.02),
        "attn_k_norm": 1.0 + nrm(ks[19], (N_SWA_LAYERS, HEAD_DIM), 0.02),
        "attn_sinks": nrm(ks[20], (N_SWA_LAYERS, N_HEADS)),
        "attn_w_o": nrm(ks[21], (N_SWA_LAYERS, N_HEADS * HEAD_DIM, D_MODEL), (N_HEADS * HEAD_DIM) ** -0.5),
        "ffn_w_gate_up": nrm(ks[22], (DEPTH, D_MODEL, 2 * D_FF), D_MODEL ** -0.5),
        "ffn_w_down": nrm(ks[23], (DEPTH, D_FF, D_MODEL), D_FF ** -0.5),
    }


def reference(x_prompt, x_sample, state_ssm_re, state_ssm_im, cache_swa_k, cache_swa_v,
              norm_mix, norm_ffn, ssm_a_re, ssm_a_im, ssm_log_dt, ssm_b_re, ssm_b_im,
              ssm_c_re, ssm_c_im, ssm_d, ssm_w_glu, attn_w_qkv, attn_q_norm, attn_k_norm,
              attn_sinks, attn_w_o, ffn_w_gate_up, ffn_w_down):
    yp = x_prompt
    ys = x_sample
    p_re, p_im, p_k, p_v = [], [], [], []
    s_re, s_im, s_k, s_v = [], [], [], []
    h0 = jnp.zeros((x_prompt.shape[0], N_GROUPS, STATE_DIM), jnp.float32)
    for i in range(DEPTH):
        j = i // N_MIXERS
        xp_n = rms_norm(yp, norm_mix[i])
        xs_n = rms_norm(ys, norm_mix[i])
        if i % N_MIXERS == 0:
            ssm_w = (ssm_a_re[j], ssm_a_im[j], ssm_log_dt[j], ssm_b_re[j], ssm_b_im[j],
                     ssm_c_re[j], ssm_c_im[j], ssm_d[j], ssm_w_glu[j])
            op, hr, hi = s5_mixer(xp_n, h0, h0, *ssm_w)
            osm, sr, si = s5_mixer(xs_n, state_ssm_re[j], state_ssm_im[j], *ssm_w)
            p_re.append(hr)
            p_im.append(hi)
            s_re.append(sr)
            s_im.append(si)
        else:
            attn_w = (attn_w_qkv[j], attn_q_norm[j], attn_k_norm[j], attn_sinks[j], attn_w_o[j])
            op, kp, vp = swa_prompt(xp_n, *attn_w)
            osm, ks_, vs_ = swa_sample(xs_n, cache_swa_k[j], cache_swa_v[j], *attn_w)
            p_k.append(kp)
            p_v.append(vp)
            s_k.append(ks_)
            s_v.append(vs_)
        yp = yp + op
        ys = ys + osm
        yp = yp + swiglu(rms_norm(yp, norm_ffn[i]), ffn_w_gate_up[i], ffn_w_down[i])
        ys = ys + swiglu(rms_norm(ys, norm_ffn[i]), ffn_w_gate_up[i], ffn_w_down[i])
    p_state_re = jnp.stack(p_re)
    p_state_im = jnp.stack(p_im)
    p_cache_k = jnp.stack(p_k)
    p_cache_v = jnp.stack(p_v)
    s_state_re = jnp.stack(s_re)
    s_state_im = jnp.stack(s_im)
    s_cache_k = jnp.stack(s_k)
    s_cache_v = jnp.stack(s_v)
    return (yp, ys, p_state_re, p_state_im, p_cache_k, p_cache_v, s_state_re, s_state_im, s_cache_k, s_cache_v)
```

```cpp
#include <hip/hip_runtime.h>
#include <hip/hip_cooperative_groups.h>
#include <cstdio>
namespace cg = cooperative_groups;

#ifndef SPLIT_LAUNCH
#define SPLIT_LAUNCH 0
#endif

#ifndef PHM
#define PHM 255
#endif
#ifndef REP_KIND
#define REP_KIND -1
#endif
#define LAS __attribute__((address_space(3)))
typedef unsigned short bf16_t;
typedef short bf16x8 __attribute__((ext_vector_type(8)));
typedef float f32x4 __attribute__((ext_vector_type(4)));
typedef unsigned u32x4 __attribute__((ext_vector_type(4)));

constexpr int DM = 1024, MP = 16384, MS = 1024, MT = MP + MS, SEQ = 2048, DFF = 2816, NQKV = 1536;
constexpr int PAST = 8192;
constexpr float EPS = 1e-6f;
constexpr size_t O_Y = 0, O_PRE = 17825792, O_PIM = 17891328, O_PK = 17956864, O_PV = 18481152, O_SRE = 19005440, O_SIM = 20054016, O_SK = 21102592, O_SV = 29491200;
constexpr size_t SZ_GLU = (size_t)2048 * 1024 * 2, SZ_QKV = (size_t)1536 * 1024 * 2, SZ_WO = (size_t)1024 * 1024 * 2, SZ_GU = (size_t)5632 * 1024 * 2, SZ_DN = (size_t)1024 * 2816 * 2;
constexpr size_t WS_GLU = 0, WS_QKVW = WS_GLU + 2 * SZ_GLU, WS_WO = WS_QKVW + 2 * SZ_QKV, WS_GU = WS_WO + 2 * SZ_WO, WS_DN = WS_GU + 4 * SZ_GU;
constexpr size_t WS_XB = WS_DN + 4 * SZ_DN, WS_RSS = WS_XB + (size_t)MT * DM * 2, WS_R1 = WS_RSS + (size_t)MT * 32 * 4;
constexpr size_t WS_H = WS_R1;
constexpr size_t WS_QKV = WS_R1;
constexpr size_t WS_Z = WS_R1 + (size_t)MT * NQKV * 2;
constexpr size_t WS_SSMC = WS_R1 + (size_t)MT * DFF * 2;
constexpr size_t WS_RS2 = WS_SSMC + 2 * 4096 * 16;
constexpr size_t WS_BAR = (WS_RS2 + (size_t)9 * MT * 8 + 255) & ~(size_t)255;
constexpr size_t WS_END = WS_BAR + 3456 * 4;
constexpr int LDS_BYTES = 131072 + 4096 + 64;

typedef unsigned long long rs2_t;
constexpr float RS2_SCALE = 1048576.0f, RS2_INV = 1.0f / (1048576.0f * 1024.0f);
__device__ __forceinline__ float rs2_to_float(rs2_t v) { return (float)(unsigned)(v >> 32) * 4294967296.0f + (float)(unsigned)v; }
struct Params { const float* in[24]; float* out; unsigned char* ws; int ph_lo, ph_hi; };
typedef const __attribute__((address_space(4))) Params KP;

typedef __bf16 bf16v2_t __attribute__((ext_vector_type(2)));
typedef float f32v2_t __attribute__((ext_vector_type(2)));
__device__ __forceinline__ unsigned cvt_pk_bf16(float lo, float hi) { const f32v2_t f = {lo, hi}; const bf16v2_t v = __builtin_convertvector(f, bf16v2_t); return __builtin_bit_cast(unsigned, v); }
__device__ __forceinline__ float bf_lo(unsigned w) { return __uint_as_float(w << 16); }
__device__ __forceinline__ float bf_hi(unsigned w) { return __uint_as_float(w & 0xffff0000u); }
__device__ __forceinline__ float sigmoidf_(float x) { return __builtin_amdgcn_rcpf(1.0f + __builtin_amdgcn_exp2f(x * -1.4426950408889634f)); }
__device__ __forceinline__ float gelu_tanh(float y) {
    const float t = y * (-2.3022081986f - 0.1029432394f * y * y);
    return y * __builtin_amdgcn_rcpf(1.0f + __builtin_amdgcn_exp2f(t)); }
__device__ __forceinline__ void rope_cs(int pos, int i, float& c, float& s) {
    constexpr double T[8] = {0.15915494309189535, 0.03086376340470123, 0.005985185712713705, 0.001160663641240061, 0.00022507907903927653, 4.364795279280289e-05, 8.464330808241401e-06, 1.6414262627950345e-06};
    const double rev = (double)pos * T[i]; const float f = (float)(rev - floor(rev));
    c = __builtin_amdgcn_cosf(f); s = __builtin_amdgcn_sinf(f);
}

__device__ __forceinline__ unsigned cvt_pk_bf16_asm(float lo, float hi) { unsigned r; asm volatile("v_cvt_pk_bf16_f32 %0, %1, %2" : "=v"(r) : "v"(lo), "v"(hi)); return r; }

namespace pg8 {
constexpr int BM = 256, BK = 64, HALF = 128, HTB = HALF * BK * 2, STAGE_BYTES = 8 * HTB, NXCD = 8, WGM = 8;
__device__ __forceinline__ int lds_byte(int r, int c) { const int st = (r >> 4) * 2 + (c >> 5), rr = r & 15, cc = c & 31, ob = rr * 64 + cc * 2; return st * 1024 + (ob ^ (((ob >> 9) & 1) << 5)); }
__device__ __forceinline__ void stage_rc(int b, int& R, int& C) { const int st = b / 1024, sb = b % 1024, swz = sb ^ (((sb >> 9) & 1) << 5); R = (st >> 1) * 16 + swz / 64; C = (st & 1) * 32 + (swz % 64) / 2; }
__device__ __forceinline__ int perm32(int rho) { const int n = rho >> 4, i = rho & 15; return 8 * (i >> 2) + 4 * n + (i & 3); }
struct Unit { int pm, pn; };
struct Gemm { const bf16_t* A; const bf16_t* Bt; int M, N, K; };
struct StaticOrder {
    int nM, nN, nwg, G, c;
    __device__ void init(int M, int N, int G_, int c_) { nM = M / BM; nN = N / BM; nwg = nM * nN; G = G_; c = c_; }
    __device__ bool next(int i, Unit& u) const {
        const long L = (long)i * G + c; if (L >= nwg) return false;
        int wgid = (int)L; { const int q = nwg / NXCD, r = nwg % NXCD, xcd = wgid % NXCD, off = wgid / NXCD; wgid = (xcd < r ? xcd * (q + 1) : r * (q + 1) + (xcd - r) * q) + off; }
        const int nig = WGM * nN, gid = wgid / nig, fm = gid * WGM, gsz = (nM - fm) < WGM ? (nM - fm) : WGM;
        u.pm = fm + ((wgid % nig) % gsz); u.pn = (wgid % nig) / gsz; return true;
    }
    __device__ __forceinline__ void a_ready(const Unit&) const {}
    __device__ __forceinline__ void done(const Unit&) const {}
};

template <class Epi, class Sched>
__device__ __forceinline__ void gemm_phase(LAS unsigned char* lds, const Gemm g, const Sched& S, const Epi& E) {
    int tid_ = threadIdx.x; asm volatile("" : "+v"(tid_));
    const int tid = tid_, wid = __builtin_amdgcn_readfirstlane(tid >> 6), lane = tid & 63, wr = wid >> 2, wc = wid & 3, fr = lane & 15, fq = lane >> 4;
    const int K = g.K, nt = K / BK;
    unsigned voffA[2], voffB[2];
#pragma unroll
    for (int i = 0; i < 2; ++i) { int R, C; stage_rc(tid * 16 + i * 8192, R, C); const int Rb = Epi::PERM ? ((R & ~31) + perm32(R & 31)) : R;
        voffA[i] = (unsigned)(R * K + C) * 2u; voffB[i] = (unsigned)(Rb * K + C) * 2u; }
    const size_t kstep = (size_t)(BK * 2);
    const size_t hstep = (size_t)HALF * K * 2;
    const size_t tstep = 2 * hstep;
    const unsigned ldsw = (unsigned)wid * 1024u;
    const int aoff = lds_byte(wr * 64 + fr, fq * 8), boff = lds_byte(wc * 32 + fr, fq * 8);
#define PG8_SA(b, h) (((b) * 2 + (h)) * HTB)
#define PG8_SB(b, h) ((4 + (b) * 2 + (h)) * HTB)
#define PG8_STAGE(bufoff, gbase, voff) do { _Pragma("unroll") for (int _i = 0; _i < 2; ++_i) \
        __builtin_amdgcn_global_load_lds((const unsigned*)((const char*)(gbase) + (voff)[_i]), (LAS unsigned*)(lds + (bufoff) + ldsw + _i * 8192), 16, 0, 0); } while (0)
#define PG8_LDA(dst, b, h) do { _Pragma("unroll") for (int m = 0; m < 4; ++m) _Pragma("unroll") for (int k = 0; k < 2; ++k) dst[m][k] = *(const LAS bf16x8*)(lds + PG8_SA(b, h) + aoff + m * 2048 + k * 1024); } while (0)
#define PG8_LDB(dst, b, h) do { _Pragma("unroll") for (int n = 0; n < 2; ++n) _Pragma("unroll") for (int k = 0; k < 2; ++k) dst[n][k] = *(const LAS bf16x8*)(lds + PG8_SB(b, h) + boff + n * 2048 + k * 1024); } while (0)
#define PG8_MMA(ai, bj, At, Bt) do { __builtin_amdgcn_s_setprio(1); _Pragma("unroll") for (int m = 0; m < 4; ++m) _Pragma("unroll") for (int n = 0; n < 2; ++n) _Pragma("unroll") for (int k = 0; k < 2; ++k) \
        acc[ai][bj][m][n] = __builtin_amdgcn_mfma_f32_16x16x32_bf16(Bt[n][k], At[m][k], acc[ai][bj][m][n], 0, 0, 0); __builtin_amdgcn_s_setprio(0); } while (0)
#define PG8_WAIT_V(n) asm volatile("s_waitcnt vmcnt(" #n ")" ::: "memory")
#define PG8_WAIT_L(n) asm volatile("s_waitcnt lgkmcnt(" #n ")" ::: "memory")
#define PG8_BAR __builtin_amdgcn_s_barrier()
#define PG8_SCHED __builtin_amdgcn_sched_barrier(0)
    Unit cur, nxt; int ui = 0;
    if (!S.next(0, cur)) return;
    f32x4 acc[2][2][4][2];
#pragma unroll
    for (int a = 0; a < 2; ++a)
#pragma unroll
        for (int b = 0; b < 2; ++b)
#pragma unroll
            for (int m = 0; m < 4; ++m)
#pragma unroll
                for (int n = 0; n < 2; ++n) acc[a][b][m][n] = (f32x4){0.f, 0.f, 0.f, 0.f};
    bf16x8 At[4][2], B0[2][2], B1[2][2];
    const char* cA = (const char*)g.A + (size_t)cur.pm * tstep; const char* cB = (const char*)g.Bt + (size_t)cur.pn * tstep;
    S.a_ready(cur);
    PG8_STAGE(PG8_SB(0, 0), cB, voffB); PG8_STAGE(PG8_SA(0, 0), cA, voffA); PG8_STAGE(PG8_SB(0, 1), cB + hstep, voffB); PG8_STAGE(PG8_SA(0, 1), cA + hstep, voffA);
    if (wr == 1) PG8_BAR;
    PG8_WAIT_V(4); PG8_BAR;
    PG8_STAGE(PG8_SB(1, 0), cB + kstep, voffB); PG8_STAGE(PG8_SA(1, 0), cA + kstep, voffA); PG8_STAGE(PG8_SB(1, 1), cB + hstep + kstep, voffB);
    PG8_WAIT_V(6); PG8_BAR;
    for (;;) {
        const bool has_next = S.next(ui + 1, nxt);
        const char* nA = has_next ? (const char*)g.A + (size_t)nxt.pm * tstep : cA; const char* nB = has_next ? (const char*)g.Bt + (size_t)nxt.pn * tstep : cB;
        for (int t = 0; t < nt; t += 2) {
            const bool last = (t == nt - 2);
            const char* a1 = cA + (size_t)(t + 1) * kstep;
            const char* a2 = last ? nA : cA + (size_t)(t + 2) * kstep; const char* b2 = last ? nB : cB + (size_t)(t + 2) * kstep;
            const char* a3 = a2 + kstep; const char* b3 = b2 + kstep;
            if (last && has_next) S.a_ready(nxt);
            PG8_LDB(B0, 0, 0); PG8_SCHED; PG8_LDA(At, 0, 0); PG8_STAGE(PG8_SA(1, 1), a1 + hstep, voffA);
            PG8_WAIT_L(8); PG8_BAR; PG8_WAIT_L(0); PG8_MMA(0, 0, At, B0); PG8_BAR; PG8_SCHED;
            PG8_LDB(B1, 0, 1); PG8_STAGE(PG8_SB(0, 0), b2, voffB);
            PG8_BAR; PG8_WAIT_L(0); PG8_MMA(0, 1, At, B1); PG8_BAR;
            PG8_LDA(At, 0, 1); PG8_STAGE(PG8_SA(0, 0), a2, voffA);
            PG8_BAR; PG8_WAIT_L(0); PG8_MMA(1, 0, At, B0); PG8_BAR; PG8_SCHED;
            PG8_STAGE(PG8_SB(0, 1), b2 + hstep, voffB);
            PG8_WAIT_V(6); PG8_BAR; PG8_MMA(1, 1, At, B1); PG8_BAR;
            PG8_LDB(B0, 1, 0); PG8_SCHED; PG8_LDA(At, 1, 0); PG8_STAGE(PG8_SA(0, 1), a2 + hstep, voffA);
            PG8_WAIT_L(8); PG8_BAR; PG8_WAIT_L(0); PG8_MMA(0, 0, At, B0); PG8_BAR; PG8_SCHED;
            PG8_LDB(B1, 1, 1); PG8_STAGE(PG8_SB(1, 0), b3, voffB);
            PG8_BAR; PG8_WAIT_L(0); PG8_MMA(0, 1, At, B1); PG8_BAR;
            PG8_LDA(At, 1, 1); PG8_STAGE(PG8_SA(1, 0), a3, voffA);
            PG8_BAR; PG8_WAIT_L(0); PG8_MMA(1, 0, At, B0); PG8_BAR; PG8_SCHED;
            PG8_STAGE(PG8_SB(1, 1), b3 + hstep, voffB);
            PG8_WAIT_V(6); PG8_BAR; PG8_MMA(1, 1, At, B1); PG8_BAR;
        }
        E(acc, cur, wr, wc, fr, fq); S.done(cur);
        if (!has_next) break;
#pragma unroll
        for (int a = 0; a < 2; ++a)
#pragma unroll
            for (int b = 0; b < 2; ++b)
#pragma unroll
                for (int m = 0; m < 4; ++m)
#pragma unroll
                    for (int n = 0; n < 2; ++n) acc[a][b][m][n] = (f32x4){0.f, 0.f, 0.f, 0.f};
        cur = nxt; cA = nA; cB = nB; ++ui;
    }
    PG8_WAIT_V(0);
    if (wr == 0) PG8_BAR;
    PG8_BAR;
#undef PG8_SA
#undef PG8_SB
#undef PG8_STAGE
#undef PG8_LDA
#undef PG8_LDB
#undef PG8_MMA
#undef PG8_WAIT_V
#undef PG8_WAIT_L
#undef PG8_BAR
#undef PG8_SCHED
}
}

typedef const f32x4 (&AccRef)[2][2][4][2];
__device__ __forceinline__ float row_rscale(const float* rss, int row, int fq) {
    const f32x4* p = (const f32x4*)(rss + (size_t)row * 32 + fq * 8);
    const f32x4 a = p[0], b = p[1];
    float s = ((a[0] + a[1]) + (a[2] + a[3])) + ((b[0] + b[1]) + (b[2] + b[3]));
    s += __shfl_xor(s, 16); s += __shfl_xor(s, 32);
    return rsqrtf(s * (1.0f / 1024.0f) + EPS);
}
__device__ __forceinline__ float wave_rscale(const float* rss, int row0, int lane) {
    const f32x4* p = (const f32x4*)(rss + (size_t)(row0 + lane) * 32);
    f32x4 v[8];
#pragma unroll
    for (int i = 0; i < 8; ++i) v[i] = p[i];
    const f32x4 t = ((v[0] + v[1]) + (v[2] + v[3])) + ((v[4] + v[5]) + (v[6] + v[7]));
    return rsqrtf(((t[0] + t[1]) + (t[2] + t[3])) * (1.0f / 1024.0f) + EPS);
}
struct EpiQKV {
    static constexpr bool PERM = true;
    bf16_t* O; const rs2_t* rs2;
    __device__ __forceinline__ void operator()(AccRef acc, const pg8::Unit& u, int wr, int wc, int fr, int fq) const {
        rs2_t rv[2][4]; float rr[2][4];
#pragma unroll
        for (int ai = 0; ai < 2; ++ai)
#pragma unroll
            for (int m = 0; m < 4; ++m) rv[ai][m] = rs2[u.pm * 256 + ai * 128 + wr * 64 + m * 16 + fr];
#pragma unroll
        for (int ai = 0; ai < 2; ++ai)
#pragma unroll
            for (int m = 0; m < 4; ++m) rr[ai][m] = rs2_to_float(rv[ai][m]);
#pragma unroll
        for (int ai = 0; ai < 2; ++ai)
#pragma unroll
            for (int m = 0; m < 4; ++m) { const int row = u.pm * 256 + ai * 128 + wr * 64 + m * 16 + fr; const float r = rsqrtf(rr[ai][m] * RS2_INV + EPS);
#pragma unroll
                for (int bj = 0; bj < 2; ++bj) { const int col0 = u.pn * 256 + bj * 128 + wc * 32 + 8 * fq; const f32x4 v0 = acc[ai][bj][m][0] * r, v1 = acc[ai][bj][m][1] * r;
                    u32x4 w; w.x = cvt_pk_bf16(v0[0], v0[1]); w.y = cvt_pk_bf16(v0[2], v0[3]); w.z = cvt_pk_bf16(v1[0], v1[1]); w.w = cvt_pk_bf16(v1[2], v1[3]);
                    *(u32x4*)(O + (size_t)row * NQKV + col0) = w; } }
    }
};
struct EpiSwiGLU {
    static constexpr bool PERM = true;
    bf16_t* H; const rs2_t* rs2;
    __device__ __forceinline__ void operator()(AccRef acc, const pg8::Unit& u, int wr, int wc, int fr, int fq) const {
        rs2_t rv[2][4]; float rr[2][4];
#pragma unroll
        for (int ai = 0; ai < 2; ++ai)
#pragma unroll
            for (int m = 0; m < 4; ++m) rv[ai][m] = rs2[u.pm * 256 + ai * 128 + wr * 64 + m * 16 + fr];
#pragma unroll
        for (int ai = 0; ai < 2; ++ai)
#pragma unroll
            for (int m = 0; m < 4; ++m) rr[ai][m] = rs2_to_float(rv[ai][m]);
#pragma unroll
        for (int ai = 0; ai < 2; ++ai)
#pragma unroll
            for (int m = 0; m < 4; ++m) { const int row = u.pm * 256 + ai * 128 + wr * 64 + m * 16 + fr; const float r = rsqrtf(rr[ai][m] * RS2_INV + EPS);
                const int col0 = u.pn * 128 + wc * 32 + 8 * fq; float h[8];
#pragma unroll
                for (int n = 0; n < 2; ++n)
#pragma unroll
                    for (int j = 0; j < 4; ++j) { const float gt = acc[ai][0][m][n][j] * r, up = acc[ai][1][m][n][j] * r; h[n * 4 + j] = gt * up * __builtin_amdgcn_rcpf(1.0f + __builtin_amdgcn_exp2f(gt * -1.4426950408889634f)); }
                u32x4 w; w.x = cvt_pk_bf16(h[0], h[1]); w.y = cvt_pk_bf16(h[2], h[3]); w.z = cvt_pk_bf16(h[4], h[5]); w.w = cvt_pk_bf16(h[6], h[7]);
                *(u32x4*)(H + (size_t)row * DFF + col0) = w; }
    }
};
__device__ __forceinline__ float resid_finish(float* X, bf16_t* XB, int row, int col0, const u32x4 xo, const f32x4 d0, const f32x4 d1) {
    const f32x4 x0 = (f32x4){bf_lo(xo.x), bf_hi(xo.x), bf_lo(xo.y), bf_hi(xo.y)} + d0, x1 = (f32x4){bf_lo(xo.z), bf_hi(xo.z), bf_lo(xo.w), bf_hi(xo.w)} + d1;
    if (X) { float* xp = X + (size_t)row * DM + col0; *(f32x4*)xp = x0; *(f32x4*)(xp + 4) = x1; return 0.f; }
    u32x4 w; w.x = cvt_pk_bf16(x0[0], x0[1]); w.y = cvt_pk_bf16(x0[2], x0[3]); w.z = cvt_pk_bf16(x1[0], x1[1]); w.w = cvt_pk_bf16(x1[2], x1[3]);
    *(u32x4*)(XB + (size_t)row * DM + col0) = w;
    float ss = ((x0[0] * x0[0] + x0[1] * x0[1]) + (x0[2] * x0[2] + x0[3] * x0[3])) + ((x1[0] * x1[0] + x1[1] * x1[1]) + (x1[2] * x1[2] + x1[3] * x1[3]));
    ss += __shfl_xor(ss, 16); ss += __shfl_xor(ss, 32);
    return ss;
}
struct EpiGLU {
    static constexpr bool PERM = true;
    float* X; bf16_t* XB; rs2_t* rss;
    __device__ __forceinline__ void operator()(AccRef acc, const pg8::Unit& u, int wr, int wc, int fr, int fq) const {
        const int col0 = u.pn * 128 + wc * 32 + 8 * fq;
        u32x4 xo[2][4];
#pragma unroll
        for (int m = 0; m < 4; ++m) xo[0][m] = *(const u32x4*)(XB + (size_t)(u.pm * 256 + wr * 64 + m * 16 + fr) * DM + col0);
#pragma unroll
        for (int ai = 0; ai < 2; ++ai) {
            if (ai == 0) {
#pragma unroll
                for (int m = 0; m < 4; ++m) xo[1][m] = *(const u32x4*)(XB + (size_t)(u.pm * 256 + 128 + wr * 64 + m * 16 + fr) * DM + col0);
            }
#pragma unroll
            for (int m = 0; m < 4; ++m) { const int row = u.pm * 256 + ai * 128 + wr * 64 + m * 16 + fr;
                f32x4 d0, d1;
#pragma unroll
                for (int j = 0; j < 4; ++j) { d0[j] = acc[ai][0][m][0][j] * sigmoidf_(acc[ai][1][m][0][j]); d1[j] = acc[ai][0][m][1][j] * sigmoidf_(acc[ai][1][m][1][j]); }
                const float ss = resid_finish(X, XB, row, col0, xo[ai][m], d0, d1);
                if (fq == 0 && !X) atomicAdd(rss + row, (rs2_t)(ss * RS2_SCALE)); }
        }
    }
};
struct EpiResid {
    static constexpr bool PERM = true;
    float* X; bf16_t* XB; rs2_t* rss;
    __device__ __forceinline__ void operator()(AccRef acc, const pg8::Unit& u, int wr, int wc, int fr, int fq) const {
        u32x4 xo[2][4]; float ssrow[4] = {0.f, 0.f, 0.f, 0.f};
#pragma unroll
        for (int m = 0; m < 4; ++m) xo[0][m] = *(const u32x4*)(XB + (size_t)(u.pm * 256 + wr * 64 + m * 16 + fr) * DM + u.pn * 256 + wc * 32 + 8 * fq);
#pragma unroll
        for (int bt = 0; bt < 4; ++bt) {
            const int ai = bt >> 1, bj = bt & 1, col0 = u.pn * 256 + bj * 128 + wc * 32 + 8 * fq;
            if (bt < 3) { const int ai2 = (bt + 1) >> 1, bj2 = (bt + 1) & 1;
#pragma unroll
                for (int m = 0; m < 4; ++m) xo[(bt + 1) & 1][m] = *(const u32x4*)(XB + (size_t)(u.pm * 256 + ai2 * 128 + wr * 64 + m * 16 + fr) * DM + u.pn * 256 + bj2 * 128 + wc * 32 + 8 * fq); }
#pragma unroll
            for (int m = 0; m < 4; ++m) { const int row = u.pm * 256 + ai * 128 + wr * 64 + m * 16 + fr;
                const float ss = resid_finish(X, XB, row, col0, xo[bt & 1][m], acc[ai][bj][m][0], acc[ai][bj][m][1]);
                if (bj == 0) ssrow[m] = ss; else if (fq == 0 && !X) atomicAdd(rss + row, (rs2_t)((ssrow[m] + ss) * RS2_SCALE)); }
        }
    }
};

struct ConvRegs { f32x4 a, b; float gs; };
__device__ __forceinline__ ConvRegs conv_load(const float* W, int N, const float* gain, int tk, int tn, int tid) {
    const int k = tid >> 3, n8 = (tid & 7) * 8;
    const float* src = W + (size_t)(tk * 64 + k) * N + tn * 64 + n8;
    ConvRegs r; r.a = *(const f32x4*)src; r.b = *(const f32x4*)(src + 4); r.gs = gain ? gain[tk * 64 + k] : 1.0f; return r;
}
__device__ __forceinline__ void conv_store(const ConvRegs& r, int K, bf16_t* Bt, int half, int tk, int tn, float* tile, int tid) {
    {
        const int k = tid >> 3, n8 = (tid & 7) * 8;
#pragma unroll
        for (int j = 0; j < 4; ++j) { tile[(n8 + j) * 65 + k] = r.a[j] * r.gs; tile[(n8 + 4 + j) * 65 + k] = r.b[j] * r.gs; }
    }
    __syncthreads();
    {
        const int n = tid >> 3, k8 = (tid & 7) * 8; const int ng = tn * 64 + n; int nd = ng;
        if (half) { const int h = ng >= half ? 1 : 0; const int j = ng - h * half; nd = (j >> 7) * 256 + h * 128 + (j & 127); }
        const float* t = tile + n * 65 + k8;
        u32x4 w; w.x = cvt_pk_bf16(t[0], t[1]); w.y = cvt_pk_bf16(t[2], t[3]); w.z = cvt_pk_bf16(t[4], t[5]); w.w = cvt_pk_bf16(t[6], t[7]);
        *(u32x4*)(Bt + (size_t)nd * K + tk * 64 + k8) = w;
    }
    __syncthreads();
}
__device__ __forceinline__ void phase_prep(KP& p, unsigned char* shm) {
    int tid_ = threadIdx.x; asm volatile("" : "+v"(tid_)); const int tid = tid_, G = gridDim.x; float* tile = (float*)shm;
    int cum = 0;
    for (int mi = 0; mi < 14; ++mi) {
        const float* W; const float* gain = nullptr; bf16_t* Bt; int K = 1024, N, half = 0;
        if (mi < 2) { W = p.in[16] + (size_t)mi * 1024 * 2048; Bt = (bf16_t*)(p.ws + WS_GLU + mi * SZ_GLU); N = 2048; half = 1024; }
        else if (mi < 4) { const int j = mi - 2; W = p.in[17] + (size_t)j * 1024 * 1536; gain = p.in[6] + (size_t)(2 * j + 1) * 1024; Bt = (bf16_t*)(p.ws + WS_QKVW + j * SZ_QKV); N = 1536; }
        else if (mi < 6) { const int j = mi - 4; W = p.in[21] + (size_t)j * 1024 * 1024; Bt = (bf16_t*)(p.ws + WS_WO + j * SZ_WO); N = 1024; }
        else if (mi < 10) { const int i = mi - 6; W = p.in[22] + (size_t)i * 1024 * 5632; gain = p.in[7] + (size_t)i * 1024; Bt = (bf16_t*)(p.ws + WS_GU + i * SZ_GU); N = 5632; half = 2816; }
        else { const int i = mi - 10; W = p.in[23] + (size_t)i * 2816 * 1024; Bt = (bf16_t*)(p.ws + WS_DN + i * SZ_DN); K = 2816; N = 1024; }
        const int ntn = N / 64, nt = (K / 64) * ntn;
        int t = (((int)blockIdx.x - cum) % G + G) % G;
        if (t < nt) {
            ConvRegs cur = conv_load(W, N, gain, t / ntn, t % ntn, tid);
            for (; t < nt; t += G) {
                const int t2 = t + G < nt ? t + G : t;
                const ConvRegs nxt = conv_load(W, N, gain, t2 / ntn, t2 % ntn, tid);
                conv_store(cur, K, Bt, half, t / ntn, t % ntn, tile, tid);
                cur = nxt;
            }
        }
        cum += nt;
    }
    const int wid = tid >> 6, lane = tid & 63;
    bf16_t* XB = (bf16_t*)(p.ws + WS_XB); rs2_t* rs2 = (rs2_t*)(p.ws + WS_RS2);
    for (int row0 = blockIdx.x * 8 + wid; row0 < MT; row0 += G * 8 * 4) {
        f32x4 v[4][4];
#pragma unroll
        for (int r = 0; r < 4; ++r) { const int row = row0 + r * G * 8; const int rc = row < MT ? row : row0;
            const float* src = (rc < MP ? p.in[0] + (size_t)rc * DM : p.in[1] + (size_t)(rc - MP) * DM) + lane * 16;
#pragma unroll
            for (int i = 0; i < 4; ++i) v[r][i] = *(const f32x4*)(src + 4 * i); }
#pragma unroll
        for (int r = 0; r < 4; ++r) { const int row = row0 + r * G * 8;
            if (row < MT) {
                float ss = 0.f;
#pragma unroll
                for (int i = 0; i < 4; ++i) ss += (v[r][i][0] * v[r][i][0] + v[r][i][1] * v[r][i][1]) + (v[r][i][2] * v[r][i][2] + v[r][i][3] * v[r][i][3]);
                u32x4 w0, w1;
                w0.x = cvt_pk_bf16(v[r][0][0], v[r][0][1]); w0.y = cvt_pk_bf16(v[r][0][2], v[r][0][3]); w0.z = cvt_pk_bf16(v[r][1][0], v[r][1][1]); w0.w = cvt_pk_bf16(v[r][1][2], v[r][1][3]);
                w1.x = cvt_pk_bf16(v[r][2][0], v[r][2][1]); w1.y = cvt_pk_bf16(v[r][2][2], v[r][2][3]); w1.z = cvt_pk_bf16(v[r][3][0], v[r][3][1]); w1.w = cvt_pk_bf16(v[r][3][2], v[r][3][3]);
                bf16_t* xb = XB + (size_t)row * DM + lane * 16; *(u32x4*)xb = w0; *(u32x4*)(xb + 8) = w1;
#pragma unroll
                for (int o = 32; o >= 1; o >>= 1) ss += __shfl_xor(ss, o);
                if (lane < 9) rs2[(size_t)lane * MT + row] = lane == 0 ? (rs2_t)(ss * RS2_SCALE) : (rs2_t)0;
            }
        }
    }
}

typedef short bf16x4 __attribute__((ext_vector_type(4)));
typedef unsigned u32x2 __attribute__((ext_vector_type(2)));
union U2B4 { u32x2 u; bf16x4 b; };
union U4B8 { u32x4 u; bf16x8 b; };
struct SsmConst { bf16x8 Abu[8]; bf16x8 Ay[4]; f32x4 dsk, gn; };
__device__ __forceinline__ u32x2 ssm_load_u(const bf16_t* XB, const rs2_t* rs2, int row, int g, int q, const f32x4 gn) {
    const u32x2 x = *(const u32x2*)(XB + (size_t)row * DM + g * 16 + 4 * q);
    const float r = rsqrtf(rs2_to_float(rs2[row]) * RS2_INV + EPS);
    u32x2 o; o.x = cvt_pk_bf16(bf_lo(x.x) * gn[0] * r, bf_hi(x.x) * gn[1] * r); o.y = cvt_pk_bf16(bf_lo(x.y) * gn[2] * r, bf_hi(x.y) * gn[3] * r); return o;
}
__device__ __forceinline__ void ssm_update(f32x4 (&hr)[4], f32x4 (&hi)[4], const f32x4 (&lr)[4], const f32x4 (&li)[4], const SsmConst& C, const u32x2 ub) {
    U4B8 cv; cv.u = (u32x4){0u, 0u, ub.x, ub.y};
#pragma unroll
    for (int kk = 0; kk < 4; ++kk) {
        const f32x4 tr = lr[kk] * hr[kk] - li[kk] * hi[kk], ti = lr[kk] * hi[kk] + li[kk] * hr[kk];
        hr[kk] = __builtin_amdgcn_mfma_f32_16x16x32_bf16(C.Abu[2 * kk], cv.b, tr, 0, 0, 0);
        hi[kk] = __builtin_amdgcn_mfma_f32_16x16x32_bf16(C.Abu[2 * kk + 1], cv.b, ti, 0, 0, 0);
    }
}
__device__ __forceinline__ void ssm_update2(f32x4 (&hr)[4], f32x4 (&hi)[4], const f32x4 (&l2r)[4], const f32x4 (&l2i)[4], const SsmConst& C, const u32x2 u0, const u32x2 u1) {
    U4B8 cv; cv.u = (u32x4){u0.x, u0.y, u1.x, u1.y};
#pragma unroll
    for (int kk = 0; kk < 4; ++kk) {
        const f32x4 tr = l2r[kk] * hr[kk] - l2i[kk] * hi[kk], ti = l2r[kk] * hi[kk] + l2i[kk] * hr[kk];
        hr[kk] = __builtin_amdgcn_mfma_f32_16x16x32_bf16(C.Abu[2 * kk], cv.b, tr, 0, 0, 0);
        hi[kk] = __builtin_amdgcn_mfma_f32_16x16x32_bf16(C.Abu[2 * kk + 1], cv.b, ti, 0, 0, 0);
    }
}
__device__ __forceinline__ void ssm_emit(const f32x4 (&hr)[4], const f32x4 (&hi)[4], const SsmConst& C, const u32x2 ub, bf16_t* zp) {
    f32x4 y = (f32x4){0.f, 0.f, 0.f, 0.f};
#pragma unroll
    for (int s = 0; s < 4; ++s) { U4B8 hb; hb.u.x = cvt_pk_bf16(hr[s][0], hr[s][1]); hb.u.y = cvt_pk_bf16(hr[s][2], hr[s][3]); hb.u.z = cvt_pk_bf16(hi[s][0], hi[s][1]); hb.u.w = cvt_pk_bf16(hi[s][2], hi[s][3]);
        y = __builtin_amdgcn_mfma_f32_16x16x32_bf16(C.Ay[s], hb.b, y, 0, 0, 0); }
    const float u0 = bf_lo(ub.x), u1 = bf_hi(ub.x), u2 = bf_lo(ub.y), u3 = bf_hi(ub.y);
    const float z0 = gelu_tanh(y[0] + C.dsk[0] * u0), z1 = gelu_tanh(y[1] + C.dsk[1] * u1), z2 = gelu_tanh(y[2] + C.dsk[2] * u2), z3 = gelu_tanh(y[3] + C.dsk[3] * u3);
    u32x2 w; w.x = cvt_pk_bf16(z0, z1); w.y = cvt_pk_bf16(z2, z3); *(u32x2*)zp = w;
}
__device__ __forceinline__ void ssm_consts(KP& p, int layer, int j, int g, int n, int q, SsmConst& C, f32x4 (&lr)[4], f32x4 (&li)[4]) {
    const f32x4* SC = (const f32x4*)(p.ws + WS_SSMC) + (size_t)(j * 64 + g) * 64;
#pragma unroll
    for (int kk = 0; kk < 4; ++kk) {
#pragma unroll
        for (int jj = 0; jj < 4; ++jj) { const f32x4 c = SC[16 * kk + 4 * q + jj]; lr[kk][jj] = c[0]; li[kk][jj] = c[1]; }
        const f32x4 c = SC[16 * kk + n]; const float fre = c[2], fim = c[3];
        const size_t bo = ((size_t)(j * 64 + g) * 64 + 16 * kk + n) * 16 + 4 * q;
        const f32x4 br = *(const f32x4*)(p.in[11] + bo), bi = *(const f32x4*)(p.in[12] + bo);
        const f32x4 re = fre * br - fim * bi, im = fre * bi + fim * br;
        const f32x4 lre = c[0] * re - c[1] * im, lim = c[0] * im + c[1] * re;
        U4B8 a, b; a.u = (u32x4){cvt_pk_bf16(lre[0], lre[1]), cvt_pk_bf16(lre[2], lre[3]), cvt_pk_bf16(re[0], re[1]), cvt_pk_bf16(re[2], re[3])};
        b.u = (u32x4){cvt_pk_bf16(lim[0], lim[1]), cvt_pk_bf16(lim[2], lim[3]), cvt_pk_bf16(im[0], im[1]), cvt_pk_bf16(im[2], im[3])};
        C.Abu[2 * kk] = a.b; C.Abu[2 * kk + 1] = b.b;
        const size_t co = ((size_t)(j * 64 + g) * 16 + n) * 64 + 16 * kk + 4 * q;
        const f32x4 cr = *(const f32x4*)(p.in[13] + co), ci = *(const f32x4*)(p.in[14] + co);
        U4B8 ay; ay.u.x = cvt_pk_bf16(cr[0], cr[1]); ay.u.y = cvt_pk_bf16(cr[2], cr[3]); ay.u.z = cvt_pk_bf16(-ci[0], -ci[1]); ay.u.w = cvt_pk_bf16(-ci[2], -ci[3]);
        C.Ay[kk] = ay.b;
    }
    C.dsk = *(const f32x4*)(p.in[15] + j * 1024 + g * 16 + 4 * q);
    C.gn = *(const f32x4*)(p.in[6] + layer * 1024 + g * 16 + 4 * q);
}
template <int SHR> __device__ __forceinline__ float dpp_shr(float x) { return __int_as_float(__builtin_amdgcn_update_dpp(0, __float_as_int(x), 0x110 + SHR, 0xf, 0xf, true)); }
template <int SHR> __device__ __forceinline__ void scan_step(f32x4& Ir, f32x4& Ii, const f32x4 Pr, const f32x4 Pi) {
#pragma unroll
    for (int jj = 0; jj < 4; ++jj) { const float sr = dpp_shr<SHR>(Ir[jj]), si = dpp_shr<SHR>(Ii[jj]);
        Ir[jj] += Pr[jj] * sr - Pi[jj] * si; Ii[jj] += Pr[jj] * si + Pi[jj] * sr; }
}
__device__ __forceinline__ void csq(f32x4& Pr, f32x4& Pi) { const f32x4 r = Pr * Pr - Pi * Pi, i = 2.0f * Pr * Pi; Pr = r; Pi = i; }
__device__ __forceinline__ void cmul_sel(f32x4& Qr, f32x4& Qi, const f32x4 Pr, const f32x4 Pi, bool on) {
    const f32x4 r = Qr * Pr - Qi * Pi, i = Qr * Pi + Qi * Pr;
#pragma unroll
    for (int jj = 0; jj < 4; ++jj) { Qr[jj] = on ? r[jj] : Qr[jj]; Qi[jj] = on ? i[jj] : Qi[jj]; }
}
__device__ __forceinline__ void phase_ssm2(KP& p, int layer, unsigned char* shm) {
    int tid_ = threadIdx.x; asm volatile("" : "+v"(tid_));
    const int j = layer >> 1, tid = tid_, wid = tid >> 6, lane = tid & 63, n = lane & 15, q = lane >> 4, G = gridDim.x;
    const bf16_t* X = (const bf16_t*)(p.ws + WS_XB); const rs2_t* rss = (const rs2_t*)(p.ws + WS_RS2) + (size_t)(2 * layer) * MT; bf16_t* Z = (bf16_t*)(p.ws + WS_Z);
    u32x2* ubuf = (u32x2*)shm + wid * (32 * 64); float* tot = (float*)(shm + 131072);
    constexpr int T = 32;
    for (int it = blockIdx.x; it < 256; it += G) {
        const int idx = 2 * it + (wid >> 2), b = idx >> 6, g = idx & 63, wsub = wid & 3;
        SsmConst C; f32x4 lr[4], li[4], hr[4], hi[4];
        ssm_consts(p, layer, j, g, n, q, C, lr, li);
        const int row0 = b * SEQ + (16 * wsub + n) * T;
#pragma unroll
        for (int kk = 0; kk < 4; ++kk) { hr[kk] = (f32x4){0.f, 0.f, 0.f, 0.f}; hi[kk] = (f32x4){0.f, 0.f, 0.f, 0.f}; }
        {
            f32x4 l2r[4], l2i[4];
#pragma unroll
            for (int kk = 0; kk < 4; ++kk) { l2r[kk] = lr[kk] * lr[kk] - li[kk] * li[kk]; l2i[kk] = 2.0f * lr[kk] * li[kk]; }
#pragma unroll 1
            for (int t = 0; t < T; t += 2) { const u32x2 u0 = ssm_load_u(X, rss, row0 + t, g, q, C.gn), u1 = ssm_load_u(X, rss, row0 + t + 1, g, q, C.gn);
                ubuf[t * 64 + lane] = u0; ubuf[(t + 1) * 64 + lane] = u1; ssm_update2(hr, hi, l2r, l2i, C, u0, u1); }
        }
#pragma unroll
        for (int kk = 0; kk < 4; ++kk) {
            f32x4 Pr = lr[kk], Pi = li[kk];
#pragma unroll
            for (int i = 0; i < 5; ++i) csq(Pr, Pi);
            scan_step<1>(hr[kk], hi[kk], Pr, Pi); csq(Pr, Pi);
            scan_step<2>(hr[kk], hi[kk], Pr, Pi); csq(Pr, Pi);
            scan_step<4>(hr[kk], hi[kk], Pr, Pi); csq(Pr, Pi);
            scan_step<8>(hr[kk], hi[kk], Pr, Pi);
            __builtin_amdgcn_sched_barrier(0);
        }
        if (it != (int)blockIdx.x) __syncthreads();
        if (n == 15) {
#pragma unroll
            for (int kk = 0; kk < 4; ++kk) { *(f32x4*)(tot + wid * 128 + q * 32 + kk * 8) = hr[kk]; *(f32x4*)(tot + wid * 128 + q * 32 + kk * 8 + 4) = hi[kk]; }
        }
        __syncthreads();
#pragma unroll
        for (int kk = 0; kk < 4; ++kk) {
            f32x4 Pr = lr[kk], Pi = li[kk];
            asm volatile("" : "+v"(Pr), "+v"(Pi));
#pragma unroll
            for (int i = 0; i < 9; ++i) csq(Pr, Pi);
            f32x4 cr = (f32x4){0.f, 0.f, 0.f, 0.f}, ci = (f32x4){0.f, 0.f, 0.f, 0.f};
            for (int w2 = 0; w2 < wsub; ++w2) {
                const f32x4 tr = *(const f32x4*)(tot + ((wid & 4) + w2) * 128 + q * 32 + kk * 8), ti = *(const f32x4*)(tot + ((wid & 4) + w2) * 128 + q * 32 + kk * 8 + 4);
                const f32x4 nr = Pr * cr - Pi * ci + tr, ni = Pr * ci + Pi * cr + ti; cr = nr; ci = ni;
            }
            if (wsub == 3 && n == 15) {
                const size_t so = ((size_t)(j * 8 + b) * 64 + g) * 64 + 4 * q + 16 * kk;
                *(f32x4*)(p.out + O_PRE + so) = hr[kk] + Pr * cr - Pi * ci; *(f32x4*)(p.out + O_PIM + so) = hi[kk] + Pr * ci + Pi * cr;
            }
            asm volatile("" : "+v"(cr), "+v"(ci));
            f32x4 Rr = lr[kk], Ri = li[kk];
            asm volatile("" : "+v"(Rr), "+v"(Ri));
#pragma unroll
            for (int i = 0; i < 5; ++i) csq(Rr, Ri);
            cmul_sel(cr, ci, Rr, Ri, (n & 1) != 0); csq(Rr, Ri);
            cmul_sel(cr, ci, Rr, Ri, (n & 2) != 0); csq(Rr, Ri);
            cmul_sel(cr, ci, Rr, Ri, (n & 4) != 0); csq(Rr, Ri);
            cmul_sel(cr, ci, Rr, Ri, (n & 8) != 0);
#pragma unroll
            for (int jj = 0; jj < 4; ++jj) { hr[kk][jj] = dpp_shr<1>(hr[kk][jj]) + cr[jj]; hi[kk][jj] = dpp_shr<1>(hi[kk][jj]) + ci[jj]; }
            __builtin_amdgcn_sched_barrier(0);
        }
#pragma unroll 1
        for (int t = 0; t < T; ++t) { const u32x2 ub = ubuf[t * 64 + lane]; ssm_update(hr, hi, lr, li, C, ub); ssm_emit(hr, hi, C, ub, Z + (size_t)(row0 + t) * DM + g * 16 + 4 * q); }
    }
    for (int it = wid * G + blockIdx.x; it < 512; it += 8 * G) {
        const int g = it & 63, b = (it >> 6) * 16 + n;
        SsmConst C; f32x4 lr[4], li[4], hr[4], hi[4];
        ssm_consts(p, layer, j, g, n, q, C, lr, li);
        const size_t so = ((size_t)(j * 128 + b) * 64 + g) * 64 + 4 * q;
#pragma unroll
        for (int kk = 0; kk < 4; ++kk) { hr[kk] = *(const f32x4*)(p.in[2] + so + 16 * kk); hi[kk] = *(const f32x4*)(p.in[3] + so + 16 * kk); }
        const int row0 = MP + b * 8;
#pragma unroll 1
        for (int t = 0; t < 8; ++t) { const u32x2 ub = ssm_load_u(X, rss, row0 + t, g, q, C.gn); ssm_update(hr, hi, lr, li, C, ub); ssm_emit(hr, hi, C, ub, Z + (size_t)(row0 + t) * DM + g * 16 + 4 * q); }
#pragma unroll
        for (int kk = 0; kk < 4; ++kk) { *(f32x4*)(p.out + O_SRE + so + 16 * kk) = hr[kk]; *(f32x4*)(p.out + O_SIM + so + 16 * kk) = hi[kk]; }
    }
}

__device__ __forceinline__ void load_row64_bf16(const bf16_t* src, float* x) {
#pragma unroll
    for (int i = 0; i < 8; ++i) { const u32x4 w = *(const u32x4*)(src + i * 8);
        x[i * 8 + 0] = bf_lo(w.x); x[i * 8 + 1] = bf_hi(w.x); x[i * 8 + 2] = bf_lo(w.y); x[i * 8 + 3] = bf_hi(w.y);
        x[i * 8 + 4] = bf_lo(w.z); x[i * 8 + 5] = bf_hi(w.z); x[i * 8 + 6] = bf_lo(w.w); x[i * 8 + 7] = bf_hi(w.w); }
}
__device__ __forceinline__ void norm_rope_q(float* q, const float* gain, int pos, float scale) {
    float ss = 0.f;
#pragma unroll
    for (int d = 0; d < 64; ++d) ss += q[d] * q[d];
    const float r = rsqrtf(ss * (1.0f / 64.0f) + EPS);
#pragma unroll
    for (int d = 0; d < 64; ++d) q[d] = q[d] * r * gain[d];
#pragma unroll
    for (int i = 0; i < 8; ++i) { float c, s; rope_cs(pos, i, c, s); const float x1 = q[i], x2 = q[i + 8]; q[i] = x1 * c - x2 * s; q[i + 8] = x2 * c + x1 * s; }
#pragma unroll
    for (int d = 0; d < 64; ++d) q[d] *= scale;
}
__device__ __forceinline__ float gain_absmax(const float* g, int lane) {
    float m = fabsf(g[lane]);
#pragma unroll
    for (int o = 32; o >= 1; o >>= 1) m = fmaxf(m, __shfl_xor(m, o));
    return m; }

__device__ __forceinline__ void phase_attn(KP& p, int layer, unsigned char* shm) {
    int tid_ = threadIdx.x; asm volatile("" : "+v"(tid_));
    const int j = layer >> 1, tid = tid_, wid = tid >> 6, lane = tid & 63, G = gridDim.x;
    const bf16_t* QKV = (const bf16_t*)(p.ws + WS_QKV); bf16_t* O = (bf16_t*)(p.ws + WS_Z);
    const float* qg = p.in[18] + j * 64; const float* kg = p.in[19] + j * 64; const float* sinks = p.in[20] + j * 16;
    const float bound = 8.0f * gain_absmax(qg, lane) * gain_absmax(kg, lane);
    bf16_t* Kb = (bf16_t*)shm;
    bf16_t* Vt = (bf16_t*)(shm + 36864);
    const int n = lane & 15, kq = lane >> 4;
    constexpr float LOG2E = 1.4426950408889634f;
    for (int it = blockIdx.x; it < 512; it += G) {
        const int qb = it & 15, kvh = (it >> 4) & 3, b = it >> 6;
        if (it != (int)blockIdx.x) __syncthreads();
        {
            const int row = tid >> 1, hf = tid & 1; const int kpos = qb * 128 - 128 + row;
            float kx[32];
            if (kpos >= 0) {
                const bf16_t* kp = QKV + (size_t)(b * SEQ + kpos) * NQKV + 1024 + kvh * 64 + hf * 32;
#pragma unroll
                for (int i = 0; i < 4; ++i) { const u32x4 w = *(const u32x4*)(kp + i * 8);
                    kx[i * 8 + 0] = bf_lo(w.x); kx[i * 8 + 1] = bf_hi(w.x); kx[i * 8 + 2] = bf_lo(w.y); kx[i * 8 + 3] = bf_hi(w.y); kx[i * 8 + 4] = bf_lo(w.z); kx[i * 8 + 5] = bf_hi(w.z); kx[i * 8 + 6] = bf_lo(w.w); kx[i * 8 + 7] = bf_hi(w.w); }
            } else {
#pragma unroll
                for (int d = 0; d < 32; ++d) kx[d] = 0.f;
            }
            float ss = 0.f;
#pragma unroll
            for (int d = 0; d < 32; ++d) ss += kx[d] * kx[d];
            ss += __shfl_xor(ss, 1);
            const float r = rsqrtf(ss * (1.0f / 64.0f) + EPS);
#pragma unroll
            for (int d4 = 0; d4 < 8; ++d4) { const f32x4 gv = *(const f32x4*)(kg + hf * 32 + 4 * d4); kx[4 * d4] *= r * gv[0]; kx[4 * d4 + 1] *= r * gv[1]; kx[4 * d4 + 2] *= r * gv[2]; kx[4 * d4 + 3] *= r * gv[3]; }
            if (hf == 0) {
#pragma unroll
                for (int i = 0; i < 8; ++i) { float c, s; rope_cs(kpos < 0 ? 0 : kpos, i, c, s); const float x1 = kx[i], x2 = kx[i + 8]; kx[i] = x1 * c - x2 * s; kx[i + 8] = x2 * c + x1 * s; }
            }
            bf16_t* kd = Kb + row * 72 + hf * 32;
#pragma unroll
            for (int i = 0; i < 4; ++i) { u32x4 w; w.x = cvt_pk_bf16(kx[8 * i], kx[8 * i + 1]); w.y = cvt_pk_bf16(kx[8 * i + 2], kx[8 * i + 3]); w.z = cvt_pk_bf16(kx[8 * i + 4], kx[8 * i + 5]); w.w = cvt_pk_bf16(kx[8 * i + 6], kx[8 * i + 7]); *(u32x4*)(kd + 8 * i) = w; }
            if (qb == 15 && row >= 128) {
                float* ck = p.out + O_PK + (((size_t)(j * 8 + b) * 128 + (row - 128)) * 4 + kvh) * 64 + hf * 32;
#pragma unroll
                for (int i = 0; i < 8; ++i) *(f32x4*)(ck + 4 * i) = (f32x4){kx[4 * i], kx[4 * i + 1], kx[4 * i + 2], kx[4 * i + 3]};
            }
        }
        {
            const int pr = tid >> 2, qd = tid & 3; const int kpos = qb * 128 - 128 + 2 * pr;
            u32x4 a0 = (u32x4){0u, 0u, 0u, 0u}, a1 = a0, b0 = a0, b1 = a0;
            if (kpos >= 0) { const bf16_t* vp = QKV + (size_t)(b * SEQ + kpos) * NQKV + 1280 + kvh * 64 + qd * 16;
                a0 = *(const u32x4*)vp; a1 = *(const u32x4*)(vp + 8); b0 = *(const u32x4*)(vp + NQKV); b1 = *(const u32x4*)(vp + NQKV + 8); }
            const unsigned av[8] = {a0.x, a0.y, a0.z, a0.w, a1.x, a1.y, a1.z, a1.w}, bv[8] = {b0.x, b0.y, b0.z, b0.w, b1.x, b1.y, b1.z, b1.w};
            unsigned* vt32 = (unsigned*)Vt;
#pragma unroll
            for (int i = 0; i < 8; ++i) {
                vt32[(qd * 16 + 2 * i) * 132 + pr] = (av[i] & 0xffffu) | (bv[i] << 16);
                vt32[(qd * 16 + 2 * i + 1) * 132 + pr] = (av[i] >> 16) | (bv[i] & 0xffff0000u);
            }
            if (qb == 15 && pr >= 64) {
                float* cv = p.out + O_PV + (((size_t)(j * 8 + b) * 128 + (2 * pr - 128)) * 4 + kvh) * 64 + qd * 16;
#pragma unroll
                for (int i = 0; i < 4; ++i) { *(f32x4*)(cv + 4 * i) = (f32x4){bf_lo(av[2 * i]), bf_hi(av[2 * i]), bf_lo(av[2 * i + 1]), bf_hi(av[2 * i + 1])};
                    *(f32x4*)(cv + 256 + 4 * i) = (f32x4){bf_lo(bv[2 * i]), bf_hi(bv[2 * i]), bf_lo(bv[2 * i + 1]), bf_hi(bv[2 * i + 1])}; }
            }
        }
        __syncthreads();
        {
            const int r = wid >> 1, w0 = (wid & 1) * 64, h = kvh * 4 + r;
            const float sk = sinks[h]; const float mh2 = fmaxf(bound, sk) * LOG2E;
            bf16x8 Qf[4][2];
#pragma unroll
            for (int qt = 0; qt < 4; ++qt) {
                const int qpos = qb * 128 + w0 + 16 * qt + n;
                const bf16_t* src = QKV + (size_t)(b * SEQ + qpos) * NQKV + h * 64 + 8 * kq;
                const u32x4 wa = *(const u32x4*)src, wb = *(const u32x4*)(src + 32);
                float x0[8] = {bf_lo(wa.x), bf_hi(wa.x), bf_lo(wa.y), bf_hi(wa.y), bf_lo(wa.z), bf_hi(wa.z), bf_lo(wa.w), bf_hi(wa.w)};
                float x1[8] = {bf_lo(wb.x), bf_hi(wb.x), bf_lo(wb.y), bf_hi(wb.y), bf_lo(wb.z), bf_hi(wb.z), bf_lo(wb.w), bf_hi(wb.w)};
                float ss = 0.f;
#pragma unroll
                for (int e = 0; e < 8; ++e) ss += x0[e] * x0[e] + x1[e] * x1[e];
                ss += __shfl_xor(ss, 16); ss += __shfl_xor(ss, 32);
                const float rr = rsqrtf(ss * (1.0f / 64.0f) + EPS);
                float ot[8];
#pragma unroll
                for (int e4 = 0; e4 < 2; ++e4) { const f32x4 ga = *(const f32x4*)(qg + 8 * kq + 4 * e4), gb = *(const f32x4*)(qg + 32 + 8 * kq + 4 * e4);
#pragma unroll
                    for (int e = 0; e < 4; ++e) { x0[4 * e4 + e] = x0[4 * e4 + e] * rr * ga[e]; x1[4 * e4 + e] = x1[4 * e4 + e] * rr * gb[e]; } }
#pragma unroll
                for (int e = 0; e < 8; ++e) ot[e] = __shfl_xor(x0[e], 16);
                if (kq < 2) {
#pragma unroll
                    for (int e = 0; e < 8; ++e) { float c, s; rope_cs(qpos, e, c, s); x0[e] = (kq == 0) ? (x0[e] * c - ot[e] * s) : (x0[e] * c + ot[e] * s); }
                }
                const float sc = 0.125f * LOG2E;
                U4B8 f0, f1;
                f0.u.x = cvt_pk_bf16(x0[0] * sc, x0[1] * sc); f0.u.y = cvt_pk_bf16(x0[2] * sc, x0[3] * sc); f0.u.z = cvt_pk_bf16(x0[4] * sc, x0[5] * sc); f0.u.w = cvt_pk_bf16(x0[6] * sc, x0[7] * sc);
                f1.u.x = cvt_pk_bf16(x1[0] * sc, x1[1] * sc); f1.u.y = cvt_pk_bf16(x1[2] * sc, x1[3] * sc); f1.u.z = cvt_pk_bf16(x1[4] * sc, x1[5] * sc); f1.u.w = cvt_pk_bf16(x1[6] * sc, x1[7] * sc);
                Qf[qt][0] = f0.b; Qf[qt][1] = f1.b;
            }
            f32x4 Oa[4][4]; float lsum[4];
#pragma unroll
            for (int dt = 0; dt < 4; ++dt)
#pragma unroll
                for (int qt = 0; qt < 4; ++qt) Oa[dt][qt] = (f32x4){0.f, 0.f, 0.f, 0.f};
#pragma unroll
            for (int qt = 0; qt < 4; ++qt) lsum[qt] = 0.f;
            for (int st = 0; st < 6; ++st) {
                const int k0 = w0 + 32 * st;
                if (qb == 0 && k0 + 31 < 128) continue;
                bf16x8 Ka[2][2], Va[4];
#pragma unroll
                for (int kt = 0; kt < 2; ++kt)
#pragma unroll
                    for (int ks = 0; ks < 2; ++ks) Ka[kt][ks] = *(const bf16x8*)(Kb + (k0 + 16 * kt + n) * 72 + ks * 32 + kq * 8);
#pragma unroll
                for (int dt = 0; dt < 4; ++dt) { const u32x2 lo = *(const u32x2*)(Vt + (16 * dt + n) * 264 + k0 + 4 * kq), hi = *(const u32x2*)(Vt + (16 * dt + n) * 264 + k0 + 16 + 4 * kq);
                    U4B8 v; v.u.x = lo.x; v.u.y = lo.y; v.u.z = hi.x; v.u.w = hi.y; Va[dt] = v.b; }
#pragma unroll
                for (int qt = 0; qt < 4; ++qt) {
                    const int qlo = w0 + 16 * qt;
                    if (k0 + 31 < qlo + 1 || k0 > qlo + 143) continue;
                    f32x4 S0 = (f32x4){0.f, 0.f, 0.f, 0.f}, S1 = S0;
                    S0 = __builtin_amdgcn_mfma_f32_16x16x32_bf16(Ka[0][0], Qf[qt][0], S0, 0, 0, 0); S0 = __builtin_amdgcn_mfma_f32_16x16x32_bf16(Ka[0][1], Qf[qt][1], S0, 0, 0, 0);
                    S1 = __builtin_amdgcn_mfma_f32_16x16x32_bf16(Ka[1][0], Qf[qt][0], S1, 0, 0, 0); S1 = __builtin_amdgcn_mfma_f32_16x16x32_bf16(Ka[1][1], Qf[qt][1], S1, 0, 0, 0);
                    float pa[4], pb[4]; float ls = 0.f;
                    const int rel = k0 - qlo;
                    if (rel >= 16 && rel + 31 <= 128 && (qb > 0 || k0 >= 128)) {
#pragma unroll
                        for (int jj = 0; jj < 4; ++jj) { pa[jj] = __builtin_amdgcn_exp2f(S0[jj] - mh2); pb[jj] = __builtin_amdgcn_exp2f(S1[jj] - mh2); ls += pa[jj] + pb[jj]; }
                    } else {
                        const int ql = qlo + n, lo = max(ql + 1, qb == 0 ? 128 : 0);
                        const unsigned span = (unsigned)(ql + 128 - lo); const int ka0 = k0 + 4 * kq - lo;
#pragma unroll
                        for (int jj = 0; jj < 4; ++jj) { const bool va = (unsigned)(ka0 + jj) <= span, vb = (unsigned)(ka0 + 16 + jj) <= span;
                            pa[jj] = va ? __builtin_amdgcn_exp2f(S0[jj] - mh2) : 0.f; pb[jj] = vb ? __builtin_amdgcn_exp2f(S1[jj] - mh2) : 0.f; ls += pa[jj] + pb[jj]; }
                    }
                    lsum[qt] += ls;
                    U4B8 pk; pk.u.x = cvt_pk_bf16(pa[0], pa[1]); pk.u.y = cvt_pk_bf16(pa[2], pa[3]); pk.u.z = cvt_pk_bf16(pb[0], pb[1]); pk.u.w = cvt_pk_bf16(pb[2], pb[3]);
#pragma unroll
                    for (int dt = 0; dt < 4; ++dt) Oa[dt][qt] = __builtin_amdgcn_mfma_f32_16x16x32_bf16(Va[dt], pk.b, Oa[dt][qt], 0, 0, 0);
                }
            }
            const float esink = __builtin_amdgcn_exp2f(sk * LOG2E - mh2);
#pragma unroll
            for (int qt = 0; qt < 4; ++qt) {
                float l = lsum[qt]; l += __shfl_xor(l, 16); l += __shfl_xor(l, 32);
                const float inv = 1.0f / (l + esink);
                const int qpos = qb * 128 + w0 + 16 * qt + n;
                bf16_t* orow = O + (size_t)(b * SEQ + qpos) * DM + h * 64;
                u32x2 w[4];
#pragma unroll
                for (int dt = 0; dt < 4; ++dt) { const f32x4 o = Oa[dt][qt] * inv; w[dt].x = cvt_pk_bf16(o[0], o[1]); w[dt].y = cvt_pk_bf16(o[2], o[3]); }
                const bool odd = (kq & 1) != 0;
#pragma unroll
                for (int pr2 = 0; pr2 < 2; ++pr2) {
                    const u32x2 own_keep = odd ? w[2 * pr2 + 1] : w[2 * pr2], send = odd ? w[2 * pr2] : w[2 * pr2 + 1];
                    u32x2 recv; recv.x = (unsigned)__shfl_xor((int)send.x, 16); recv.y = (unsigned)__shfl_xor((int)send.y, 16);
                    u32x4 st; st.x = odd ? recv.x : own_keep.x; st.y = odd ? recv.y : own_keep.y; st.z = odd ? own_keep.x : recv.x; st.w = odd ? own_keep.y : recv.y;
                    *(u32x4*)(orow + 16 * (2 * pr2 + (odd ? 1 : 0)) + 4 * (kq & ~1)) = st;
                }
            }
        }
    }
    const float* ck_in = p.in[4]; const float* cv_in = p.in[5];
    for (int it = blockIdx.x; it < 512; it += G) {
        const int b = it >> 2, kvh = it & 3;
        __syncthreads();
        const int vpr = tid >> 3, vod = tid & 7;
        const size_t vso = (((size_t)(j * 128 + b) * 128 + 2 * vpr) * 4 + kvh) * 64 + vod * 8;
        const f32x4 va0 = *(const f32x4*)(cv_in + vso), va1 = *(const f32x4*)(cv_in + vso + 4), vb0 = *(const f32x4*)(cv_in + vso + 256), vb1 = *(const f32x4*)(cv_in + vso + 260);
        {
            const int row = tid >> 2, part = tid & 3;
            const size_t so = (((size_t)(j * 128 + b) * 128 + row) * 4 + kvh) * 64 + part * 16;
            const f32x4 v0 = *(const f32x4*)(ck_in + so), v1 = *(const f32x4*)(ck_in + so + 4), v2 = *(const f32x4*)(ck_in + so + 8), v3 = *(const f32x4*)(ck_in + so + 12);
            u32x4 w0, w1; w0.x = cvt_pk_bf16(v0[0], v0[1]); w0.y = cvt_pk_bf16(v0[2], v0[3]); w0.z = cvt_pk_bf16(v1[0], v1[1]); w0.w = cvt_pk_bf16(v1[2], v1[3]);
            w1.x = cvt_pk_bf16(v2[0], v2[1]); w1.y = cvt_pk_bf16(v2[2], v2[3]); w1.z = cvt_pk_bf16(v3[0], v3[1]); w1.w = cvt_pk_bf16(v3[2], v3[3]);
            *(u32x4*)(Kb + row * 72 + part * 16) = w0; *(u32x4*)(Kb + row * 72 + part * 16 + 8) = w1;
        }
        {
            const int pr = vpr, od = vod; const size_t so = vso;
            const f32x4 a0 = va0, a1 = va1, b0 = vb0, b1 = vb1;
            unsigned* vt32 = (unsigned*)Vt;
#pragma unroll
            for (int i = 0; i < 4; ++i) { vt32[(od * 8 + i) * 132 + pr] = cvt_pk_bf16(a0[i], b0[i]); vt32[(od * 8 + 4 + i) * 132 + pr] = cvt_pk_bf16(a1[i], b1[i]); }
        }
        if (wid == 2) {
            const int jn = lane >> 3, part = lane & 7; const int tok = MP + b * 8 + jn;
            const bf16_t* kp = QKV + (size_t)tok * NQKV + 1024 + kvh * 64 + part * 8;
            const u32x4 w = *(const u32x4*)kp;
            float kx[8] = {bf_lo(w.x), bf_hi(w.x), bf_lo(w.y), bf_hi(w.y), bf_lo(w.z), bf_hi(w.z), bf_lo(w.w), bf_hi(w.w)};
            float ss = 0.f;
#pragma unroll
            for (int e = 0; e < 8; ++e) ss += kx[e] * kx[e];
            ss += __shfl_xor(ss, 1); ss += __shfl_xor(ss, 2); ss += __shfl_xor(ss, 4);
            const float r = rsqrtf(ss * (1.0f / 64.0f) + EPS);
            float ot[8];
#pragma unroll
            for (int e4 = 0; e4 < 2; ++e4) { const f32x4 gv = *(const f32x4*)(kg + part * 8 + 4 * e4); kx[4 * e4] *= r * gv[0]; kx[4 * e4 + 1] *= r * gv[1]; kx[4 * e4 + 2] *= r * gv[2]; kx[4 * e4 + 3] *= r * gv[3]; }
#pragma unroll
            for (int e = 0; e < 8; ++e) ot[e] = __shfl_xor(kx[e], 1);
            if (part < 2) {
#pragma unroll
                for (int e = 0; e < 8; ++e) { float c, s; rope_cs(PAST + jn, e, c, s); kx[e] = (part == 0) ? (kx[e] * c - ot[e] * s) : (kx[e] * c + ot[e] * s); }
            }
            u32x4 wk; wk.x = cvt_pk_bf16(kx[0], kx[1]); wk.y = cvt_pk_bf16(kx[2], kx[3]); wk.z = cvt_pk_bf16(kx[4], kx[5]); wk.w = cvt_pk_bf16(kx[6], kx[7]);
            *(u32x4*)(Kb + (128 + jn) * 72 + part * 8) = wk;
            float* ck = p.out + O_SK + (((size_t)(j * 128 + b) * 128 + (120 + jn)) * 4 + kvh) * 64 + part * 8;
            *(f32x4*)ck = (f32x4){kx[0], kx[1], kx[2], kx[3]}; *(f32x4*)(ck + 4) = (f32x4){kx[4], kx[5], kx[6], kx[7]};
        }
        if (wid == 3) {
            const int pr = lane >> 3, od = lane & 7;
            unsigned* vt32 = (unsigned*)Vt;
            if (pr < 4) {
                const bf16_t* vp = QKV + (size_t)(MP + b * 8 + 2 * pr) * NQKV + 1280 + kvh * 64 + od * 8;
                const u32x4 a = *(const u32x4*)vp, bq = *(const u32x4*)(vp + NQKV);
                const unsigned av[4] = {a.x, a.y, a.z, a.w}, bv[4] = {bq.x, bq.y, bq.z, bq.w};
#pragma unroll
                for (int i = 0; i < 4; ++i) { vt32[(od * 8 + 2 * i) * 132 + 64 + pr] = (av[i] & 0xffffu) | (bv[i] << 16); vt32[(od * 8 + 2 * i + 1) * 132 + 64 + pr] = (av[i] >> 16) | (bv[i] & 0xffff0000u); }
                float* cv = p.out + O_SV + (((size_t)(j * 128 + b) * 128 + (120 + 2 * pr)) * 4 + kvh) * 64 + od * 8;
                *(f32x4*)cv = (f32x4){bf_lo(av[0]), bf_hi(av[0]), bf_lo(av[1]), bf_hi(av[1])}; *(f32x4*)(cv + 4) = (f32x4){bf_lo(av[2]), bf_hi(av[2]), bf_lo(av[3]), bf_hi(av[3])};
                *(f32x4*)(cv + 256) = (f32x4){bf_lo(bv[0]), bf_hi(bv[0]), bf_lo(bv[1]), bf_hi(bv[1])}; *(f32x4*)(cv + 260) = (f32x4){bf_lo(bv[2]), bf_hi(bv[2]), bf_lo(bv[3]), bf_hi(bv[3])};
            }
            for (int i = lane; i < 64 * 12; i += 64) vt32[(i / 12) * 132 + 68 + (i % 12)] = 0u;
            for (int i = lane; i < 24 * 8; i += 64) *(u32x4*)(Kb + (136 + i / 8) * 72 + (i % 8) * 8) = (u32x4){0u, 0u, 0u, 0u};
        }
        __syncthreads();
        if (wid < 2) {
            const int qt = wid, pair = 16 * qt + n, qi = pair >> 2, r = pair & 3, h = kvh * 4 + r; const int tok = MP + b * 8 + qi;
            const float sk = sinks[h]; const float mh2 = fmaxf(bound, sk) * LOG2E;
            bf16x8 Qf[2];
            {
                const bf16_t* src = QKV + (size_t)tok * NQKV + h * 64 + 8 * kq;
                const u32x4 wa = *(const u32x4*)src, wb = *(const u32x4*)(src + 32);
                float x0[8] = {bf_lo(wa.x), bf_hi(wa.x), bf_lo(wa.y), bf_hi(wa.y), bf_lo(wa.z), bf_hi(wa.z), bf_lo(wa.w), bf_hi(wa.w)};
                float x1[8] = {bf_lo(wb.x), bf_hi(wb.x), bf_lo(wb.y), bf_hi(wb.y), bf_lo(wb.z), bf_hi(wb.z), bf_lo(wb.w), bf_hi(wb.w)};
                float ss = 0.f;
#pragma unroll
                for (int e = 0; e < 8; ++e) ss += x0[e] * x0[e] + x1[e] * x1[e];
                ss += __shfl_xor(ss, 16); ss += __shfl_xor(ss, 32);
                const float rr = rsqrtf(ss * (1.0f / 64.0f) + EPS);
                float ot[8];
#pragma unroll
                for (int e4 = 0; e4 < 2; ++e4) { const f32x4 ga = *(const f32x4*)(qg + 8 * kq + 4 * e4), gb = *(const f32x4*)(qg + 32 + 8 * kq + 4 * e4);
#pragma unroll
                    for (int e = 0; e < 4; ++e) { x0[4 * e4 + e] = x0[4 * e4 + e] * rr * ga[e]; x1[4 * e4 + e] = x1[4 * e4 + e] * rr * gb[e]; } }
#pragma unroll
                for (int e = 0; e < 8; ++e) ot[e] = __shfl_xor(x0[e], 16);
                if (kq < 2) {
#pragma unroll
                    for (int e = 0; e < 8; ++e) { float c, s; rope_cs(PAST + qi, e, c, s); x0[e] = (kq == 0) ? (x0[e] * c - ot[e] * s) : (x0[e] * c + ot[e] * s); }
                }
                const float sc = 0.125f * LOG2E;
                U4B8 f0, f1;
                f0.u.x = cvt_pk_bf16(x0[0] * sc, x0[1] * sc); f0.u.y = cvt_pk_bf16(x0[2] * sc, x0[3] * sc); f0.u.z = cvt_pk_bf16(x0[4] * sc, x0[5] * sc); f0.u.w = cvt_pk_bf16(x0[6] * sc, x0[7] * sc);
                f1.u.x = cvt_pk_bf16(x1[0] * sc, x1[1] * sc); f1.u.y = cvt_pk_bf16(x1[2] * sc, x1[3] * sc); f1.u.z = cvt_pk_bf16(x1[4] * sc, x1[5] * sc); f1.u.w = cvt_pk_bf16(x1[6] * sc, x1[7] * sc);
                Qf[0] = f0.b; Qf[1] = f1.b;
            }
            f32x4 Oa[4]; float lsum = 0.f;
#pragma unroll
            for (int dt = 0; dt < 4; ++dt) Oa[dt] = (f32x4){0.f, 0.f, 0.f, 0.f};
#pragma unroll
            for (int st = 0; st < 5; ++st) {
                const int k0 = 32 * st;
                bf16x8 Ka[2][2], Va[4];
#pragma unroll
                for (int kt = 0; kt < 2; ++kt)
#pragma unroll
                    for (int ks = 0; ks < 2; ++ks) Ka[kt][ks] = *(const bf16x8*)(Kb + (k0 + 16 * kt + n) * 72 + ks * 32 + kq * 8);
#pragma unroll
                for (int dt = 0; dt < 4; ++dt) { const u32x2 lo = *(const u32x2*)(Vt + (16 * dt + n) * 264 + k0 + 4 * kq), hi = *(const u32x2*)(Vt + (16 * dt + n) * 264 + k0 + 16 + 4 * kq);
                    U4B8 v; v.u.x = lo.x; v.u.y = lo.y; v.u.z = hi.x; v.u.w = hi.y; Va[dt] = v.b; }
                f32x4 S0 = (f32x4){0.f, 0.f, 0.f, 0.f}, S1 = S0;
                S0 = __builtin_amdgcn_mfma_f32_16x16x32_bf16(Ka[0][0], Qf[0], S0, 0, 0, 0); S0 = __builtin_amdgcn_mfma_f32_16x16x32_bf16(Ka[0][1], Qf[1], S0, 0, 0, 0);
                S1 = __builtin_amdgcn_mfma_f32_16x16x32_bf16(Ka[1][0], Qf[0], S1, 0, 0, 0); S1 = __builtin_amdgcn_mfma_f32_16x16x32_bf16(Ka[1][1], Qf[1], S1, 0, 0, 0);
                float pa[4], pb[4];
                if (st >= 1 && st <= 3) {
#pragma unroll
                    for (int jj = 0; jj < 4; ++jj) { pa[jj] = __builtin_amdgcn_exp2f(S0[jj] - mh2); pb[jj] = __builtin_amdgcn_exp2f(S1[jj] - mh2); lsum += pa[jj] + pb[jj]; }
                } else {
                    const int ka0 = k0 + 4 * kq - (qi + 1);
#pragma unroll
                    for (int jj = 0; jj < 4; ++jj) { const bool va = (unsigned)(ka0 + jj) <= 127u, vb = (unsigned)(ka0 + 16 + jj) <= 127u;
                        pa[jj] = va ? __builtin_amdgcn_exp2f(S0[jj] - mh2) : 0.f; pb[jj] = vb ? __builtin_amdgcn_exp2f(S1[jj] - mh2) : 0.f; lsum += pa[jj] + pb[jj]; }
                }
                U4B8 pk; pk.u.x = cvt_pk_bf16(pa[0], pa[1]); pk.u.y = cvt_pk_bf16(pa[2], pa[3]); pk.u.z = cvt_pk_bf16(pb[0], pb[1]); pk.u.w = cvt_pk_bf16(pb[2], pb[3]);
#pragma unroll
                for (int dt = 0; dt < 4; ++dt) Oa[dt] = __builtin_amdgcn_mfma_f32_16x16x32_bf16(Va[dt], pk.b, Oa[dt], 0, 0, 0);
            }
            lsum += __shfl_xor(lsum, 16); lsum += __shfl_xor(lsum, 32);
            const float inv = 1.0f / (lsum + __builtin_amdgcn_exp2f(sk * LOG2E - mh2));
            bf16_t* op = O + (size_t)tok * DM + h * 64 + 4 * kq;
#pragma unroll
            for (int dt = 0; dt < 4; ++dt) { const f32x4 o = Oa[dt] * inv; u32x2 w; w.x = cvt_pk_bf16(o[0], o[1]); w.y = cvt_pk_bf16(o[2], o[3]); *(u32x2*)(op + 16 * dt) = w; }
        }
    }
}

template <bool GLU>
__device__ __forceinline__ void sgemm_tile(const bf16_t* A, const bf16_t* Bt, int K, float* X, bf16_t* XB, rs2_t* rs2, float* lds) {
    int tid_ = threadIdx.x; asm volatile("" : "+v"(tid_));
    const int tid = tid_, wid = tid >> 6, lane = tid & 63, n = lane & 15, kq = lane >> 4;
    constexpr int NCT = GLU ? 32 : 16, CW = GLU ? 32 : 64, NT = 16 * NCT;
    const int kbase = wid * (K >> 3), nsteps = K >> 8;
    for (int t = blockIdx.x; t < NT; t += gridDim.x) {
        const int rt0 = (t / NCT) * 64, ct0 = (t % NCT) * CW;
        const bf16_t* ap[4]; const bf16_t* bp[4];
#pragma unroll
        for (int r = 0; r < 4; ++r) ap[r] = A + (size_t)(MP + rt0 + 16 * r + n) * K + kbase + 8 * kq;
#pragma unroll
        for (int c = 0; c < 4; ++c) { int brow;
            if (GLU) { const int col = ct0 + 16 * (c & 1) + n; brow = (col >> 7) * 256 + (col & 127) + (c >> 1) * 128; }
            else brow = ct0 + 16 * c + n;
            bp[c] = Bt + (size_t)brow * K + kbase + 8 * kq; }
        f32x4 acc[4][4];
#pragma unroll
        for (int r = 0; r < 4; ++r)
#pragma unroll
            for (int c = 0; c < 4; ++c) acc[r][c] = (f32x4){0.f, 0.f, 0.f, 0.f};
        for (int s0 = 0; s0 < nsteps; s0 += 4) {
            bf16x8 af[4][4], bf[4][4];
#pragma unroll
            for (int u = 0; u < 4; ++u) { const int st = (s0 + u < nsteps) ? s0 + u : nsteps - 1;
#pragma unroll
                for (int r = 0; r < 4; ++r) af[u][r] = *(const bf16x8*)(ap[r] + 32 * st);
#pragma unroll
                for (int c = 0; c < 4; ++c) bf[u][c] = *(const bf16x8*)(bp[c] + 32 * st); }
#pragma unroll
            for (int u = 0; u < 4; ++u) { if (s0 + u < nsteps) {
#pragma unroll
                for (int r = 0; r < 4; ++r)
#pragma unroll
                    for (int c = 0; c < 4; ++c) acc[r][c] = __builtin_amdgcn_mfma_f32_16x16x32_bf16(bf[u][c], af[u][r], acc[r][c], 0, 0, 0); } }
        }
        __syncthreads();
#pragma unroll
        for (int r = 0; r < 4; ++r)
#pragma unroll
            for (int c = 0; c < 4; ++c) *(f32x4*)(lds + wid * 4096 + (16 * r + n) * 64 + 16 * c + 4 * kq) = acc[r][c];
        __syncthreads();
        const int row = MP + rt0 + (tid >> 3);
        const float* lp = lds + (tid >> 3) * 64;
        float ss = 0.f;
        if (GLU) {
            const int c4 = (tid & 7) * 4; f32x4 av = (f32x4){0.f, 0.f, 0.f, 0.f}, gv = av;
#pragma unroll
            for (int w = 0; w < 8; ++w) { av += *(const f32x4*)(lp + w * 4096 + c4); gv += *(const f32x4*)(lp + w * 4096 + 32 + c4); }
            f32x4 d;
#pragma unroll
            for (int jj = 0; jj < 4; ++jj) d[jj] = av[jj] * sigmoidf_(gv[jj]);
            const u32x2 xo = *(const u32x2*)(XB + (size_t)row * DM + ct0 + c4);
            const f32x4 x0 = (f32x4){bf_lo(xo.x), bf_hi(xo.x), bf_lo(xo.y), bf_hi(xo.y)} + d;
            if (X) *(f32x4*)(X + (size_t)row * DM + ct0 + c4) = x0;
            u32x2 w2; w2.x = cvt_pk_bf16(x0[0], x0[1]); w2.y = cvt_pk_bf16(x0[2], x0[3]); *(u32x2*)(XB + (size_t)row * DM + ct0 + c4) = w2;
            ss = (x0[0] * x0[0] + x0[1] * x0[1]) + (x0[2] * x0[2] + x0[3] * x0[3]);
        } else {
            const int c8 = (tid & 7) * 8; f32x4 d0 = (f32x4){0.f, 0.f, 0.f, 0.f}, d1 = d0;
#pragma unroll
            for (int w = 0; w < 8; ++w) { d0 += *(const f32x4*)(lp + w * 4096 + c8); d1 += *(const f32x4*)(lp + w * 4096 + c8 + 4); }
            const u32x4 xo = *(const u32x4*)(XB + (size_t)row * DM + ct0 + c8);
            const f32x4 x0 = (f32x4){bf_lo(xo.x), bf_hi(xo.x), bf_lo(xo.y), bf_hi(xo.y)} + d0, x1 = (f32x4){bf_lo(xo.z), bf_hi(xo.z), bf_lo(xo.w), bf_hi(xo.w)} + d1;
            if (X) { float* xp = X + (size_t)row * DM + ct0 + c8; *(f32x4*)xp = x0; *(f32x4*)(xp + 4) = x1; continue; }
            u32x4 w4; w4.x = cvt_pk_bf16(x0[0], x0[1]); w4.y = cvt_pk_bf16(x0[2], x0[3]); w4.z = cvt_pk_bf16(x1[0], x1[1]); w4.w = cvt_pk_bf16(x1[2], x1[3]);
            *(u32x4*)(XB + (size_t)row * DM + ct0 + c8) = w4;
            ss = ((x0[0] * x0[0] + x0[1] * x0[1]) + (x0[2] * x0[2] + x0[3] * x0[3])) + ((x1[0] * x1[0] + x1[1] * x1[1]) + (x1[2] * x1[2] + x1[3] * x1[3]));
        }
        ss += __shfl_xor(ss, 1); ss += __shfl_xor(ss, 2); ss += __shfl_xor(ss, 4);
        if ((tid & 7) == 0) atomicAdd(rs2 + row, (rs2_t)(ss * RS2_SCALE));
    }
}

__device__ __forceinline__ void cache_shift_copy(KP& p, int j, int ic, int nic) {
    int tid_ = threadIdx.x; asm volatile("" : "+v"(tid_)); const int tid = tid_;
    for (int r = ic; r < 256; r += nic) {
        const int kv = r >> 7, b = r & 127;
        const f32x4* src = (const f32x4*)((kv ? p.in[5] : p.in[4]) + ((size_t)(j * 128 + b) * 128 + 8) * 256);
        f32x4* dst = (f32x4*)(p.out + (kv ? O_SV : O_SK) + ((size_t)(j * 128 + b) * 128) * 256);
        f32x4 v[15];
#pragma unroll
        for (int i = 0; i < 15; ++i) v[i] = src[i * 512 + tid];
#pragma unroll
        for (int i = 0; i < 15; ++i) dst[i * 512 + tid] = v[i];
    }
}

#define XB_TMO      128
#define XB_XCNT(j)  (256  + 64 * (j))
#define XB_XSUB(j)  (1280 + 64 * (j))
#define XB_XGEN(j)  (2304 + 64 * (j))
#define XB_TOP      3328
#define XB_TOPGEN   3392
#define XCD_BAR_WORDS 3456
#define XB_SPIN_CAP (1u << 18)
__device__ __forceinline__ unsigned xb_ld(unsigned* p)              { return __hip_atomic_load(p, __ATOMIC_RELAXED, __HIP_MEMORY_SCOPE_AGENT); }
__device__ __forceinline__ unsigned xb_add(unsigned* p, unsigned v) { return __hip_atomic_fetch_add(p, v, __ATOMIC_RELAXED, __HIP_MEMORY_SCOPE_AGENT); }
__device__ __forceinline__ unsigned xb_xcc_id() { return (unsigned)__builtin_amdgcn_s_getreg((3 << 11) | 20) & 0xFu; }
#define XB_SPIN(cond, bar) do { unsigned _sp = 0; while (cond) { __builtin_amdgcn_s_sleep(1); \
    if ((++_sp & 255u) == 0u) { if (xb_ld(&(bar)[XB_TMO])) break; if (_sp > XB_SPIN_CAP) { atomicAdd(&(bar)[XB_TMO], 1u); break; } } } } while (0)
struct XcdBarrier { unsigned* bar; unsigned x; volatile LAS unsigned* st; };
__device__ __forceinline__ XcdBarrier xcd_barrier_post(unsigned* bar, volatile LAS unsigned* st) {
    XcdBarrier b; b.bar = bar; b.x = xb_xcc_id(); b.st = st;
    if (threadIdx.x == 0) (void)xb_add(&bar[XB_XCNT(b.x)], 1u);
    return b;
}
__device__ __forceinline__ void xcd_barrier_complete(unsigned* bar, unsigned x, unsigned& nloc, unsigned& nx) {
    const unsigned G = gridDim.x * gridDim.y * gridDim.z;
    unsigned sum, cnt, mine, sp = 0u;
    for (;;) {
        sum = 0u; cnt = 0u; mine = 0u;
#pragma unroll
        for (unsigned j = 0; j < 16; ++j) { const unsigned c = xb_ld(&bar[XB_XCNT(j)]); sum += c; cnt += (c > 0u) ? 1u : 0u; mine = (j == x) ? c : mine; }
        if (sum == G) break;
        __builtin_amdgcn_s_sleep(1);
        if ((++sp & 255u) == 0u) { if (xb_ld(&bar[XB_TMO])) break; if (sp > XB_SPIN_CAP) { atomicAdd(&bar[XB_TMO], 1u); break; } }
    }
    nloc = mine > 0u ? mine : 1u; nx = cnt > 0u ? cnt : 1u;
}
__device__ __forceinline__ void xcd_barrier(const XcdBarrier& b) {
    asm volatile("s_waitcnt vmcnt(0)" ::: "memory");
    __syncthreads();
    if (threadIdx.x == 0) {
        unsigned* bar = b.bar;
        __builtin_amdgcn_s_waitcnt(0);
        unsigned nloc = b.st[0], nx = b.st[1];
        if (nloc == 0u) { xcd_barrier_complete(bar, b.x, nloc, nx); b.st[0] = nloc; b.st[1] = nx; }
        const unsigned old = xb_add(&bar[XB_XSUB(b.x)], 1u);
        const unsigned gen = old / nloc;
        if (old + 1u == (gen + 1u) * nloc) {
            __builtin_amdgcn_fence(__ATOMIC_RELEASE, "agent");
            asm volatile("s_waitcnt vmcnt(0)" ::: "memory");
            const unsigned og = xb_add(&bar[XB_TOP], 1u);
            const unsigned tg = og / nx;
            if (og + 1u == (tg + 1u) * nx) xb_add(&bar[XB_TOPGEN], 1u);
            else XB_SPIN(xb_ld(&bar[XB_TOPGEN]) == tg, bar);
            __builtin_amdgcn_fence(__ATOMIC_ACQUIRE, "agent");
            xb_add(&bar[XB_XGEN(b.x)], 1u);
            asm volatile("s_waitcnt vmcnt(0)" ::: "memory");
        } else {
            XB_SPIN(xb_ld(&bar[XB_XGEN(b.x)]) == gen, bar);
            __builtin_amdgcn_fence(__ATOMIC_ACQUIRE, "agent");
            asm volatile("s_waitcnt vmcnt(0)" ::: "memory");
        }
    }
    __syncthreads();
}

struct EpiAny {
    static constexpr bool PERM = true;
    int kind; float* X; bf16_t* XB; rs2_t* rss; const rs2_t* rsin; bf16_t* O;
    __device__ __forceinline__ void operator()(AccRef acc, const pg8::Unit& u, int wr, int wc, int fr, int fq) const {
        if (kind == 0) { EpiGLU E; E.X = X; E.XB = XB; E.rss = rss; E(acc, u, wr, wc, fr, fq); }
        else if (kind == 1) { EpiSwiGLU E; E.H = O; E.rs2 = rsin; E(acc, u, wr, wc, fr, fq); }
        else if (kind == 2) { EpiResid E; E.X = X; E.XB = XB; E.rss = rss; E(acc, u, wr, wc, fr, fq); }
        else { EpiQKV E; E.O = O; E.rs2 = rsin; E(acc, u, wr, wc, fr, fq); }
    }
};

__global__ void __launch_bounds__(512, 2) mega(Params p_) {
    KP& p = *(KP*)__builtin_amdgcn_kernarg_segment_ptr();
    extern __shared__ __attribute__((aligned(16))) unsigned char shm[];
    cg::grid_group grid = cg::this_grid();
    volatile LAS unsigned* bst = (volatile LAS unsigned*)((LAS unsigned char*)shm + 131072 + 4096);
    if (threadIdx.x == 0) { bst[0] = 0u; bst[1] = 0u; }
    __syncthreads();
    const XcdBarrier xbar = xcd_barrier_post((unsigned*)(p.ws + WS_BAR), bst);
    if (p.ph_lo == 0) {
        const int gi = blockIdx.x * 512 + threadIdx.x;
        if (gi < 2 * 4096) {
            const float are = p.in[8][gi], aim = p.in[9][gi]; const float dtf = expf(p.in[10][gi >> 6]);
            const float mag = expf(are * dtf);
            const double rev = (double)aim * (double)dtf * 0.15915494309189535;
            const float ang = (float)((rev - rint(rev)) * 6.283185307179586);
            float sn, cs; sincosf(ang, &sn, &cs);
            const float lr = mag * cs, li = mag * sn;
            const float den = are * are + aim * aim, nr = lr - 1.0f, ni = li;
            f32x4 o; o[0] = lr; o[1] = li; o[2] = (nr * are + ni * aim) / den; o[3] = (ni * are - nr * aim) / den;
            ((f32x4*)(p.ws + WS_SSMC))[gi] = o;
        }
    }
    for (int ph = p.ph_lo; ph < p.ph_hi; ++ph) {
        if (ph > p.ph_lo) { if (p.ph_hi > 1000) grid.sync(); else xcd_barrier(xbar); }
        if (ph == 0) { if (PHM & 1) phase_prep(p, shm); continue; }
        const int q = ph - 1, pair = q / 9, rem = q % 9;
        const int layer = rem < 4 ? 2 * pair : 2 * pair + 1, kind = rem;
        const int j = layer >> 1;
        if (kind == 0) { if (PHM & 2) { phase_ssm2(p, layer, shm); if (REP_KIND == 0) { xcd_barrier(xbar); phase_ssm2(p, layer, shm); } } }
        else if (kind == 5) { if (PHM & 4) { phase_attn(p, layer, shm); if (REP_KIND == 5) { xcd_barrier(xbar); phase_attn(p, layer, shm); } } }
        else if (PHM & 8) {
            rs2_t* RS2 = (rs2_t*)(p.ws + WS_RS2);
            EpiAny E; E.X = (layer == 3 && kind == 8) ? p.out : nullptr; E.XB = (bf16_t*)(p.ws + WS_XB); E.O = nullptr;
            E.rss = RS2 + (size_t)((kind == 3 || kind == 8) ? 2 + 2 * layer : 1 + 2 * layer) * MT;
            E.rsin = RS2 + (size_t)((kind == 2 || kind == 7) ? 1 + 2 * layer : 2 * layer) * MT;
            pg8::Gemm g; g.M = MT;
            if (kind == 1) { E.kind = 0; g.A = (const bf16_t*)(p.ws + WS_Z); g.Bt = (const bf16_t*)(p.ws + WS_GLU + j * SZ_GLU); g.N = 2048; g.K = 1024; }
            else if (kind == 2 || kind == 7) { E.kind = 1; E.O = (bf16_t*)(p.ws + WS_H); g.A = E.XB; g.Bt = (const bf16_t*)(p.ws + WS_GU + layer * SZ_GU); g.N = 5632; g.K = 1024; }
            else if (kind == 3 || kind == 8) { E.kind = 2; g.A = (const bf16_t*)(p.ws + WS_H); g.Bt = (const bf16_t*)(p.ws + WS_DN + layer * SZ_DN); g.N = 1024; g.K = 2816; }
            else if (kind == 4) { E.kind = 3; E.O = (bf16_t*)(p.ws + WS_QKV); g.A = E.XB; g.Bt = (const bf16_t*)(p.ws + WS_QKVW + j * SZ_QKV); g.N = 1536; g.K = 1024; }
            else { E.kind = 2; g.A = (const bf16_t*)(p.ws + WS_Z); g.Bt = (const bf16_t*)(p.ws + WS_WO + j * SZ_WO); g.N = 1024; g.K = 1024; }
            const bool split = (E.kind == 0 || E.kind == 2);
            if (split) g.M = MP;
            pg8::StaticOrder S; S.init(g.M, g.N, (int)gridDim.x, (int)blockIdx.x);
            pg8::gemm_phase<EpiAny, pg8::StaticOrder>((LAS unsigned char*)shm, g, S, E);
            if (kind == 4) { const int G_ = (int)gridDim.x, nbusy = S.nwg - G_;
                if (nbusy >= 0 && nbusy < G_ && (int)blockIdx.x >= nbusy) cache_shift_copy(p, j, (int)blockIdx.x - nbusy, G_ - nbusy);
                else if (nbusy < 0 || nbusy >= G_) cache_shift_copy(p, j, (int)blockIdx.x, G_); }
            if (E.kind == 0) sgemm_tile<true>(g.A, g.Bt, g.K, E.X, E.XB, E.rss, (float*)shm);
            else if (E.kind == 2) sgemm_tile<false>(g.A, g.Bt, g.K, E.X, E.XB, E.rss, (float*)shm);
        }
    }
}

extern "C" void kernel_launch(void* const* d_in, const int* in_sizes, int n_in, void* d_out, int out_size, void* d_ws, size_t ws_size, hipStream_t stream) {
    static int grid = 0;
    if (grid == 0) {
        int dev = 0, cus = 0, per_cu = 0;
        hipGetDevice(&dev); hipDeviceGetAttribute(&cus, hipDeviceAttributeMultiprocessorCount, dev);
        if (hipFuncSetAttribute((const void*)mega, hipFuncAttributeMaxDynamicSharedMemorySize, LDS_BYTES) != hipSuccess) fprintf(stderr, "kernel_launch: hipFuncSetAttribute failed\n");
        if (hipOccupancyMaxActiveBlocksPerMultiprocessor(&per_cu, (const void*)mega, 512, LDS_BYTES) != hipSuccess || per_cu < 1) { fprintf(stderr, "kernel_launch: occupancy query gave %d\n", per_cu); per_cu = 1; }
        (void)hipGetLastError();
        if (cus <= 0) cus = 256;
        grid = cus * 1;
        if (ws_size < WS_END) fprintf(stderr, "kernel_launch: workspace too small: %zu < %zu\n", ws_size, (size_t)WS_END);
    }
    if (hipMemsetAsync((char*)d_ws + WS_BAR, 0, 3456 * 4, stream) != hipSuccess) fprintf(stderr, "kernel_launch: memset of the barrier words failed\n");
    Params p{};
    for (int i = 0; i < 24; ++i) p.in[i] = (const float*)d_in[i];
    p.out = (float*)d_out; p.ws = (unsigned char*)d_ws;
    const int NPH = 19;
#if SPLIT_LAUNCH
    for (int ph = 0; ph < NPH; ++ph) {
        p.ph_lo = ph; p.ph_hi = ph + 1;
        void* args[] = {&p};
        hipError_t e = hipLaunchCooperativeKernel((const void*)mega, dim3(grid), dim3(512), args, LDS_BYTES, stream);
        if (e != hipSuccess) { fprintf(stderr, "kernel_launch: cooperative launch (phase %d) failed: %s\n", ph, hipGetErrorString(e)); break; }
    }
#else
    p.ph_lo = 0; p.ph_hi = NPH;
    void* args[] = {&p};
    hipError_t e = hipLaunchCooperativeKernel((const void*)mega, dim3(grid), dim3(512), args, LDS_BYTES, stream);
    if (e != hipSuccess) fprintf(stderr, "kernel_launch: cooperative launch failed: %s (grid %d)\n", hipGetErrorString(e), grid);
#endif
}
```

```cpp
#include <hip/hip_runtime.h>
#include <hip/hip_cooperative_groups.h>
#include <cstdio>
namespace cg = cooperative_groups;

#ifndef SPLIT_LAUNCH
#define SPLIT_LAUNCH 0
#endif

#ifndef PHM
#define PHM 255
#endif
#ifndef REP_KIND
#define REP_KIND -1
#endif
#define LAS __attribute__((address_space(3)))
typedef unsigned short bf16_t;
typedef short bf16x8 __attribute__((ext_vector_type(8)));
typedef float f32x4 __attribute__((ext_vector_type(4)));
typedef unsigned u32x4 __attribute__((ext_vector_type(4)));

constexpr int DM = 1024, MP = 16384, MS = 1024, MT = MP + MS, SEQ = 2048, DFF = 2816, NQKV = 1536;
constexpr int PAST = 8192;
constexpr float EPS = 1e-6f;
constexpr size_t O_Y = 0, O_PRE = 17825792, O_PIM = 17891328, O_PK = 17956864, O_PV = 18481152, O_SRE = 19005440, O_SIM = 20054016, O_SK = 21102592, O_SV = 29491200;
constexpr size_t SZ_GLU = (size_t)2048 * 1024 * 2, SZ_QKV = (size_t)1536 * 1024 * 2, SZ_WO = (size_t)1024 * 1024 * 2, SZ_GU = (size_t)5632 * 1024 * 2, SZ_DN = (size_t)1024 * 2816 * 2;
constexpr size_t WS_GLU = 0, WS_QKVW = WS_GLU + 2 * SZ_GLU, WS_WO = WS_QKVW + 2 * SZ_QKV, WS_GU = WS_WO + 2 * SZ_WO, WS_DN = WS_GU + 4 * SZ_GU;
constexpr size_t WS_XB = WS_DN + 4 * SZ_DN, WS_RSS = WS_XB + (size_t)MT * DM * 2, WS_R1 = WS_RSS + (size_t)MT * 32 * 4;
constexpr size_t WS_H = WS_R1;
constexpr size_t WS_QKV = WS_R1;
constexpr size_t WS_Z = WS_R1 + (size_t)MT * NQKV * 2;
constexpr size_t WS_SSMC = WS_R1 + (size_t)MT * DFF * 2;
constexpr size_t WS_RS2 = WS_SSMC + 2 * 4096 * 16;
constexpr size_t WS_BAR = (WS_RS2 + (size_t)9 * MT * 8 + 255) & ~(size_t)255;
constexpr size_t WS_END = WS_BAR + 3456 * 4;
constexpr int LDS_BYTES = 131072 + 4096 + 64;

typedef unsigned long long rs2_t;
constexpr float RS2_SCALE = 1048576.0f, RS2_INV = 1.0f / (1048576.0f * 1024.0f);
__device__ __forceinline__ float rs2_to_float(rs2_t v) { return (float)(unsigned)(v >> 32) * 4294967296.0f + (float)(unsigned)v; }
struct Params { const float* in[24]; float* out; unsigned char* ws; int ph_lo, ph_hi; };
typedef const __attribute__((address_space(4))) Params KP;

typedef __bf16 bf16v2_t __attribute__((ext_vector_type(2)));
typedef float f32v2_t __attribute__((ext_vector_type(2)));
__device__ __forceinline__ unsigned cvt_pk_bf16(float lo, float hi) { const f32v2_t f = {lo, hi}; const bf16v2_t v = __builtin_convertvector(f, bf16v2_t); return __builtin_bit_cast(unsigned, v); }
__device__ __forceinline__ float bf_lo(unsigned w) { return __uint_as_float(w << 16); }
__device__ __forceinline__ float bf_hi(unsigned w) { return __uint_as_float(w & 0xffff0000u); }
__device__ __forceinline__ float sigmoidf_(float x) { return __builtin_amdgcn_rcpf(1.0f + __builtin_amdgcn_exp2f(x * -1.4426950408889634f)); }
__device__ __forceinline__ float gelu_tanh(float y) {
    const float t = y * (-2.3022081986f - 0.1029432394f * y * y);
    return y * __builtin_amdgcn_rcpf(1.0f + __builtin_amdgcn_exp2f(t)); }
__device__ __forceinline__ void rope_cs(int pos, int i, float& c, float& s) {
    constexpr double T[8] = {0.15915494309189535, 0.03086376340470123, 0.005985185712713705, 0.001160663641240061, 0.00022507907903927653, 4.364795279280289e-05, 8.464330808241401e-06, 1.6414262627950345e-06};
    const double rev = (double)pos * T[i]; const float f = (float)(rev - floor(rev));
    c = __builtin_amdgcn_cosf(f); s = __builtin_amdgcn_sinf(f);
}

__device__ __forceinline__ unsigned cvt_pk_bf16_asm(float lo, float hi) { unsigned r; asm volatile("v_cvt_pk_bf16_f32 %0, %1, %2" : "=v"(r) : "v"(lo), "v"(hi)); return r; }

namespace pg8 {
constexpr int BM = 256, BK = 64, HALF = 128, HTB = HALF * BK * 2, STAGE_BYTES = 8 * HTB, NXCD = 8, WGM = 8;
__device__ __forceinline__ int lds_byte(int r, int c) { const int st = (r >> 4) * 2 + (c >> 5), rr = r & 15, cc = c & 31, ob = rr * 64 + cc * 2; return st * 1024 + (ob ^ (((ob >> 9) & 1) << 5)); }
__device__ __forceinline__ void stage_rc(int b, int& R, int& C) { const int st = b / 1024, sb = b % 1024, swz = sb ^ (((sb >> 9) & 1) << 5); R = (st >> 1) * 16 + swz / 64; C = (st & 1) * 32 + (swz % 64) / 2; }
__device__ __forceinline__ int perm32(int rho) { const int n = rho >> 4, i = rho & 15; return 8 * (i >> 2) + 4 * n + (i & 3); }
struct Unit { int pm, pn; };
struct Gemm { const bf16_t* A; const bf16_t* Bt; int M, N, K; };
struct StaticOrder {
    int nM, nN, nwg, G, c;
    __device__ void init(int M, int N, int G_, int c_) { nM = M / BM; nN = N / BM; nwg = nM * nN; G = G_; c = c_; }
    __device__ bool next(int i, Unit& u) const {
        const long L = (long)i * G + c; if (L >= nwg) return false;
        int wgid = (int)L; { const int q = nwg / NXCD, r = nwg % NXCD, xcd = wgid % NXCD, off = wgid / NXCD; wgid = (xcd < r ? xcd * (q + 1) : r * (q + 1) + (xcd - r) * q) + off; }
        const int nig = WGM * nN, gid = wgid / nig, fm = gid * WGM, gsz = (nM - fm) < WGM ? (nM - fm) : WGM;
        u.pm = fm + ((wgid % nig) % gsz); u.pn = (wgid % nig) / gsz; return true;
    }
    __device__ __forceinline__ void a_ready(const Unit&) const {}
    __device__ __forceinline__ void done(const Unit&) const {}
};

template <class Epi, class Sched>
__device__ __forceinline__ void gemm_phase(LAS unsigned char* lds, const Gemm g, const Sched& S, const Epi& E) {
    int tid_ = threadIdx.x; asm volatile("" : "+v"(tid_));
    const int tid = tid_, wid = __builtin_amdgcn_readfirstlane(tid >> 6), lane = tid & 63, wr = wid >> 2, wc = wid & 3, fr = lane & 15, fq = lane >> 4;
    const int K = g.K, nt = K / BK;
    unsigned voffA[2], voffB[2];
#pragma unroll
    for (int i = 0; i < 2; ++i) { int R, C; stage_rc(tid * 16 + i * 8192, R, C); const int Rb = Epi::PERM ? ((R & ~31) + perm32(R & 31)) : R;
        voffA[i] = (unsigned)(R * K + C) * 2u; voffB[i] = (unsigned)(Rb * K + C) * 2u; }
    const size_t kstep = (size_t)(BK * 2);
    const size_t hstep = (size_t)HALF * K * 2;
    const size_t tstep = 2 * hstep;
    const unsigned ldsw = (unsigned)wid * 1024u;
    const int aoff = lds_byte(wr * 64 + fr, fq * 8), boff = lds_byte(wc * 32 + fr, fq * 8);
#define PG8_SA(b, h) (((b) * 2 + (h)) * HTB)
#define PG8_SB(b, h) ((4 + (b) * 2 + (h)) * HTB)
#define PG8_STAGE(bufoff, gbase, voff) do { _Pragma("unroll") for (int _i = 0; _i < 2; ++_i) \
        __builtin_amdgcn_global_load_lds((const unsigned*)((const char*)(gbase) + (voff)[_i]), (LAS unsigned*)(lds + (bufoff) + ldsw + _i * 8192), 16, 0, 0); } while (0)
#define PG8_LDA(dst, b, h) do { _Pragma("unroll") for (int m = 0; m < 4; ++m) _Pragma("unroll") for (int k = 0; k < 2; ++k) dst[m][k] = *(const LAS bf16x8*)(lds + PG8_SA(b, h) + aoff + m * 2048 + k * 1024); } while (0)
#define PG8_LDB(dst, b, h) do { _Pragma("unroll") for (int n = 0; n < 2; ++n) _Pragma("unroll") for (int k = 0; k < 2; ++k) dst[n][k] = *(const LAS bf16x8*)(lds + PG8_SB(b, h) + boff + n * 2048 + k * 1024); } while (0)
#define PG8_MMA(ai, bj, At, Bt) do { __builtin_amdgcn_s_setprio(1); _Pragma("unroll") for (int m = 0; m < 4; ++m) _Pragma("unroll") for (int n = 0; n < 2; ++n) _Pragma("unroll") for (int k = 0; k < 2; ++k) \
        acc[ai][bj][m][n] = __builtin_amdgcn_mfma_f32_16x16x32_bf16(Bt[n][k], At[m][k], acc[ai][bj][m][n], 0, 0, 0); __builtin_amdgcn_s_setprio(0); } while (0)
#define PG8_WAIT_V(n) asm volatile("s_waitcnt vmcnt(" #n ")" ::: "memory")
#define PG8_WAIT_L(n) asm volatile("s_waitcnt lgkmcnt(" #n ")" ::: "memory")
#define PG8_BAR __builtin_amdgcn_s_barrier()
#define PG8_SCHED __builtin_amdgcn_sched_barrier(0)
    Unit cur, nxt; int ui = 0;
    if (!S.next(0, cur)) return;
    f32x4 acc[2][2][4][2];
#pragma unroll
    for (int a = 0; a < 2; ++a)
#pragma unroll
        for (int b = 0; b < 2; ++b)
#pragma unroll
            for (int m = 0; m < 4; ++m)
#pragma unroll
                for (int n = 0; n < 2; ++n) acc[a][b][m][n] = (f32x4){0.f, 0.f, 0.f, 0.f};
    bf16x8 At[4][2], B0[2][2], B1[2][2];
    const char* cA = (const char*)g.A + (size_t)cur.pm * tstep; const char* cB = (const char*)g.Bt + (size_t)cur.pn * tstep;
    S.a_ready(cur);
    PG8_STAGE(PG8_SB(0, 0), cB, voffB); PG8_STAGE(PG8_SA(0, 0), cA, voffA); PG8_STAGE(PG8_SB(0, 1), cB + hstep, voffB); PG8_STAGE(PG8_SA(0, 1), cA + hstep, voffA);
    if (wr == 1) PG8_BAR;
    PG8_WAIT_V(4); PG8_BAR;
    PG8_STAGE(PG8_SB(1, 0), cB + kstep, voffB); PG8_STAGE(PG8_SA(1, 0), cA + kstep, voffA); PG8_STAGE(PG8_SB(1, 1), cB + hstep + kstep, voffB);
    PG8_WAIT_V(6); PG8_BAR;
    for (;;) {
        const bool has_next = S.next(ui + 1, nxt);
        const char* nA = has_next ? (const char*)g.A + (size_t)nxt.pm * tstep : cA; const char* nB = has_next ? (const char*)g.Bt + (size_t)nxt.pn * tstep : cB;
        for (int t = 0; t < nt; t += 2) {
            const bool last = (t == nt - 2);
            const char* a1 = cA + (size_t)(t + 1) * kstep;
            const char* a2 = last ? nA : cA + (size_t)(t + 2) * kstep; const char* b2 = last ? nB : cB + (size_t)(t + 2) * kstep;
            const char* a3 = a2 + kstep; const char* b3 = b2 + kstep;
            if (last && has_next) S.a_ready(nxt);
            PG8_LDB(B0, 0, 0); PG8_SCHED; PG8_LDA(At, 0, 0); PG8_STAGE(PG8_SA(1, 1), a1 + hstep, voffA);
            PG8_WAIT_L(8); PG8_BAR; PG8_WAIT_L(0); PG8_MMA(0, 0, At, B0); PG8_BAR; PG8_SCHED;
            PG8_LDB(B1, 0, 1); PG8_STAGE(PG8_SB(0, 0), b2, voffB);
            PG8_BAR; PG8_WAIT_L(0); PG8_MMA(0, 1, At, B1); PG8_BAR;
            PG8_LDA(At, 0, 1); PG8_STAGE(PG8_SA(0, 0), a2, voffA);
            PG8_BAR; PG8_WAIT_L(0); PG8_MMA(1, 0, At, B0); PG8_BAR; PG8_SCHED;
            PG8_STAGE(PG8_SB(0, 1), b2 + hstep, voffB);
            PG8_WAIT_V(6); PG8_BAR; PG8_MMA(1, 1, At, B1); PG8_BAR;
            PG8_LDB(B0, 1, 0); PG8_SCHED; PG8_LDA(At, 1, 0); PG8_STAGE(PG8_SA(0, 1), a2 + hstep, voffA);
            PG8_WAIT_L(8); PG8_BAR; PG8_WAIT_L(0); PG8_MMA(0, 0, At, B0); PG8_BAR; PG8_SCHED;
            PG8_LDB(B1, 1, 1); PG8_STAGE(PG8_SB(1, 0), b3, voffB);
            PG8_BAR; PG8_WAIT_L(0); PG8_MMA(0, 1, At, B1); PG8_BAR;
            PG8_LDA(At, 1, 1); PG8_STAGE(PG8_SA(1, 0), a3, voffA);
            PG8_BAR; PG8_WAIT_L(0); PG8_MMA(1, 0, At, B0); PG8_BAR; PG8_SCHED;
            PG8_STAGE(PG8_SB(1, 1), b3 + hstep, voffB);
            PG8_WAIT_V(6); PG8_BAR; PG8_MMA(1, 1, At, B1); PG8_BAR;
        }
        E(acc, cur, wr, wc, fr, fq); S.done(cur);
        if (!has_next) break;
#pragma unroll
        for (int a = 0; a < 2; ++a)
#pragma unroll
            for (int b = 0; b < 2; ++b)
#pragma unroll
                for (int m = 0; m < 4; ++m)
#pragma unroll
                    for (int n = 0; n < 2; ++n) acc[a][b][m][n] = (f32x4){0.f, 0.f, 0.f, 0.f};
        cur = nxt; cA = nA; cB = nB; ++ui;
    }
    PG8_WAIT_V(0);
    if (wr == 0) PG8_BAR;
    PG8_BAR;
#undef PG8_SA
#undef PG8_SB
#undef PG8_STAGE
#undef PG8_LDA
#undef PG8_LDB
#undef PG8_MMA
#undef PG8_WAIT_V
#undef PG8_WAIT_L
#undef PG8_BAR
#undef PG8_SCHED
}
}

typedef const f32x4 (&AccRef)[2][2][4][2];
__device__ __forceinline__ float row_rscale(const float* rss, int row, int fq) {
    const f32x4* p = (const f32x4*)(rss + (size_t)row * 32 + fq * 8);
    const f32x4 a = p[0], b = p[1];
    float s = ((a[0] + a[1]) + (a[2] + a[3])) + ((b[0] + b[1]) + (b[2] + b[3]));
    s += __shfl_xor(s, 16); s += __shfl_xor(s, 32);
    return rsqrtf(s * (1.0f / 1024.0f) + EPS);
}
__device__ __forceinline__ float wave_rscale(const float* rss, int row0, int lane) {
    const f32x4* p = (const f32x4*)(rss + (size_t)(row0 + lane) * 32);
    f32x4 v[8];
#pragma unroll
    for (int i = 0; i < 8; ++i) v[i] = p[i];
    const f32x4 t = ((v[0] + v[1]) + (v[2] + v[3])) + ((v[4] + v[5]) + (v[6] + v[7]));
    return rsqrtf(((t[0] + t[1]) + (t[2] + t[3])) * (1.0f / 1024.0f) + EPS);
}
struct EpiQKV {
    static constexpr bool PERM = true;
    bf16_t* O; const rs2_t* rs2;
    __device__ __forceinline__ void operator()(AccRef acc, const pg8::Unit& u, int wr, int wc, int fr, int fq) const {
        rs2_t rv[2][4]; float rr[2][4];
#pragma unroll
        for (int ai = 0; ai < 2; ++ai)
#pragma unroll
            for (int m = 0; m < 4; ++m) rv[ai][m] = rs2[u.pm * 256 + ai * 128 + wr * 64 + m * 16 + fr];
#pragma unroll
        for (int ai = 0; ai < 2; ++ai)
#pragma unroll
            for (int m = 0; m < 4; ++m) rr[ai][m] = rs2_to_float(rv[ai][m]);
#pragma unroll
        for (int ai = 0; ai < 2; ++ai)
#pragma unroll
            for (int m = 0; m < 4; ++m) { const int row = u.pm * 256 + ai * 128 + wr * 64 + m * 16 + fr; const float r = rsqrtf(rr[ai][m] * RS2_INV + EPS);
#pragma unroll
                for (int bj = 0; bj < 2; ++bj) { const int col0 = u.pn * 256 + bj * 128 + wc * 32 + 8 * fq; const f32x4 v0 = acc[ai][bj][m][0] * r, v1 = acc[ai][bj][m][1] * r;
                    u32x4 w; w.x = cvt_pk_bf16(v0[0], v0[1]); w.y = cvt_pk_bf16(v0[2], v0[3]); w.z = cvt_pk_bf16(v1[0], v1[1]); w.w = cvt_pk_bf16(v1[2], v1[3]);
                    *(u32x4*)(O + (size_t)row * NQKV + col0) = w; } }
    }
};
struct EpiSwiGLU {
    static constexpr bool PERM = true;
    bf16_t* H; const rs2_t* rs2;
    __device__ __forceinline__ void operator()(AccRef acc, const pg8::Unit& u, int wr, int wc, int fr, int fq) const {
        rs2_t rv[2][4]; float rr[2][4];
#pragma unroll
        for (int ai = 0; ai < 2; ++ai)
#pragma unroll
            for (int m = 0; m < 4; ++m) rv[ai][m] = rs2[u.pm * 256 + ai * 128 + wr * 64 + m * 16 + fr];
#pragma unroll
        for (int ai = 0; ai < 2; ++ai)
#pragma unroll
            for (int m = 0; m < 4; ++m) rr[ai][m] = rs2_to_float(rv[ai][m]);
#pragma unroll
        for (int ai = 0; ai < 2; ++ai)
#pragma unroll
            for (int m = 0; m < 4; ++m) { const int row = u.pm * 256 + ai * 128 + wr * 64 + m * 16 + fr; const float r = rsqrtf(rr[ai][m] * RS2_INV + EPS);
                const int col0 = u.pn * 128 + wc * 32 + 8 * fq; float h[8];
#pragma unroll
                for (int n = 0; n < 2; ++n)
#pragma unroll
                    for (int j = 0; j < 4; ++j) { const float gt = acc[ai][0][m][n][j] * r, up = acc[ai][1][m][n][j] * r; h[n * 4 + j] = gt * up * __builtin_amdgcn_rcpf(1.0f + __builtin_amdgcn_exp2f(gt * -1.4426950408889634f)); }
                u32x4 w; w.x = cvt_pk_bf16(h[0], h[1]); w.y = cvt_pk_bf16(h[2], h[3]); w.z = cvt_pk_bf16(h[4], h[5]); w.w = cvt_pk_bf16(h[6], h[7]);
                *(u32x4*)(H + (size_t)row * DFF + col0) = w; }
    }
};
__device__ __forceinline__ float resid_finish(float* X, bf16_t* XB, int row, int col0, const u32x4 xo, const f32x4 d0, const f32x4 d1) {
    const f32x4 x0 = (f32x4){bf_lo(xo.x), bf_hi(xo.x), bf_lo(xo.y), bf_hi(xo.y)} + d0, x1 = (f32x4){bf_lo(xo.z), bf_hi(xo.z), bf_lo(xo.w), bf_hi(xo.w)} + d1;
    if (X) { float* xp = X + (size_t)row * DM + col0; *(f32x4*)xp = x0; *(f32x4*)(xp + 4) = x1; return 0.f; }
    u32x4 w; w.x = cvt_pk_bf16(x0[0], x0[1]); w.y = cvt_pk_bf16(x0[2], x0[3]); w.z = cvt_pk_bf16(x1[0], x1[1]); w.w = cvt_pk_bf16(x1[2], x1[3]);
    *(u32x4*)(XB + (size_t)row * DM + col0) = w;
    float ss = ((x0[0] * x0[0] + x0[1] * x0[1]) + (x0[2] * x0[2] + x0[3] * x0[3])) + ((x1[0] * x1[0] + x1[1] * x1[1]) + (x1[2] * x1[2] + x1[3] * x1[3]));
    ss += __shfl_xor(ss, 16); ss += __shfl_xor(ss, 32);
    return ss;
}
struct EpiGLU {
    static constexpr bool PERM = true;
    float* X; bf16_t* XB; rs2_t* rss;
    __device__ __forceinline__ void operator()(AccRef acc, const pg8::Unit& u, int wr, int wc, int fr, int fq) const {
        const int col0 = u.pn * 128 + wc * 32 + 8 * fq;
        u32x4 xo[2][4];
#pragma unroll
        for (int m = 0; m < 4; ++m) xo[0][m] = *(const u32x4*)(XB + (size_t)(u.pm * 256 + wr * 64 + m * 16 + fr) * DM + col0);
#pragma unroll
        for (int ai = 0; ai < 2; ++ai) {
            if (ai == 0) {
#pragma unroll
                for (int m = 0; m < 4; ++m) xo[1][m] = *(const u32x4*)(XB + (size_t)(u.pm * 256 + 128 + wr * 64 + m * 16 + fr) * DM + col0);
            }
#pragma unroll
            for (int m = 0; m < 4; ++m) { const int row = u.pm * 256 + ai * 128 + wr * 64 + m * 16 + fr;
                f32x4 d0, d1;
#pragma unroll
                for (int j = 0; j < 4; ++j) { d0[j] = acc[ai][0][m][0][j] * sigmoidf_(acc[ai][1][m][0][j]); d1[j] = acc[ai][0][m][1][j] * sigmoidf_(acc[ai][1][m][1][j]); }
                const float ss = resid_finish(X, XB, row, col0, xo[ai][m], d0, d1);
                if (fq == 0 && !X) atomicAdd(rss + row, (rs2_t)(ss * RS2_SCALE)); }
        }
    }
};
struct EpiResid {
    static constexpr bool PERM = true;
    float* X; bf16_t* XB; rs2_t* rss;
    __device__ __forceinline__ void operator()(AccRef acc, const pg8::Unit& u, int wr, int wc, int fr, int fq) const {
        u32x4 xo[2][4]; float ssrow[4] = {0.f, 0.f, 0.f, 0.f};
#pragma unroll
        for (int m = 0; m < 4; ++m) xo[0][m] = *(const u32x4*)(XB + (size_t)(u.pm * 256 + wr * 64 + m * 16 + fr) * DM + u.pn * 256 + wc * 32 + 8 * fq);
#pragma unroll
        for (int bt = 0; bt < 4; ++bt) {
            const int ai = bt >> 1, bj = bt & 1, col0 = u.pn * 256 + bj * 128 + wc * 32 + 8 * fq;
            if (bt < 3) { const int ai2 = (bt + 1) >> 1, bj2 = (bt + 1) & 1;
#pragma unroll
                for (int m = 0; m < 4; ++m) xo[(bt + 1) & 1][m] = *(const u32x4*)(XB + (size_t)(u.pm * 256 + ai2 * 128 + wr * 64 + m * 16 + fr) * DM + u.pn * 256 + bj2 * 128 + wc * 32 + 8 * fq); }
#pragma unroll
            for (int m = 0; m < 4; ++m) { const int row = u.pm * 256 + ai * 128 + wr * 64 + m * 16 + fr;
                const float ss = resid_finish(X, XB, row, col0, xo[bt & 1][m], acc[ai][bj][m][0], acc[ai][bj][m][1]);
                if (bj == 0) ssrow[m] = ss; else if (fq == 0 && !X) atomicAdd(rss + row, (rs2_t)((ssrow[m] + ss) * RS2_SCALE)); }
        }
    }
};

struct ConvRegs { f32x4 a, b; float gs; };
__device__ __forceinline__ ConvRegs conv_load(const float* W, int N, const float* gain, int tk, int tn, int tid) {
    const int k = tid >> 3, n8 = (tid & 7) * 8;
    const float* src = W + (size_t)(tk * 64 + k) * N + tn * 64 + n8;
    ConvRegs r; r.a = *(const f32x4*)src; r.b = *(const f32x4*)(src + 4); r.gs = gain ? gain[tk * 64 + k] : 1.0f; return r;
}
__device__ __forceinline__ void conv_store(const ConvRegs& r, int K, bf16_t* Bt, int half, int tk, int tn, float* tile, int tid) {
    {
        const int k = tid >> 3, n8 = (tid & 7) * 8;
#pragma unroll
        for (int j = 0; j < 4; ++j) { tile[(n8 + j) * 65 + k] = r.a[j] * r.gs; tile[(n8 + 4 + j) * 65 + k] = r.b[j] * r.gs; }
    }
    __syncthreads();
    {
        const int n = tid >> 3, k8 = (tid & 7) * 8; const int ng = tn * 64 + n; int nd = ng;
        if (half) { const int h = ng >= half ? 1 : 0; const int j = ng - h * half; nd = (j >> 7) * 256 + h * 128 + (j & 127); }
        const float* t = tile + n * 65 + k8;
        u32x4 w; w.x = cvt_pk_bf16(t[0], t[1]); w.y = cvt_pk_bf16(t[2], t[3]); w.z = cvt_pk_bf16(t[4], t[5]); w.w = cvt_pk_bf16(t[6], t[7]);
        *(u32x4*)(Bt + (size_t)nd * K + tk * 64 + k8) = w;
    }
    __syncthreads();
}
__device__ __forceinline__ void phase_prep(KP& p, unsigned char* shm) {
    int tid_ = threadIdx.x; asm volatile("" : "+v"(tid_)); const int tid = tid_, G = gridDim.x; float* tile = (float*)shm;
    int cum = 0;
    for (int mi = 0; mi < 14; ++mi) {
        const float* W; const float* gain = nullptr; bf16_t* Bt; int K = 1024, N, half = 0;
        if (mi < 2) { W = p.in[16] + (size_t)mi * 1024 * 2048; Bt = (bf16_t*)(p.ws + WS_GLU + mi * SZ_GLU); N = 2048; half = 1024; }
        else if (mi < 4) { const int j = mi - 2; W = p.in[17] + (size_t)j * 1024 * 1536; gain = p.in[6] + (size_t)(2 * j + 1) * 1024; Bt = (bf16_t*)(p.ws + WS_QKVW + j * SZ_QKV); N = 1536; }
        else if (mi < 6) { const int j = mi - 4; W = p.in[21] + (size_t)j * 1024 * 1024; Bt = (bf16_t*)(p.ws + WS_WO + j * SZ_WO); N = 1024; }
        else if (mi < 10) { const int i = mi - 6; W = p.in[22] + (size_t)i * 1024 * 5632; gain = p.in[7] + (size_t)i * 1024; Bt = (bf16_t*)(p.ws + WS_GU + i * SZ_GU); N = 5632; half = 2816; }
        else { const int i = mi - 10; W = p.in[23] + (size_t)i * 2816 * 1024; Bt = (bf16_t*)(p.ws + WS_DN + i * SZ_DN); K = 2816; N = 1024; }
        const int ntn = N / 64, nt = (K / 64) * ntn;
        int t = (((int)blockIdx.x - cum) % G + G) % G;
        if (t < nt) {
            ConvRegs cur = conv_load(W, N, gain, t / ntn, t % ntn, tid);
            for (; t < nt; t += G) {
                const int t2 = t + G < nt ? t + G : t;
                const ConvRegs nxt = conv_load(W, N, gain, t2 / ntn, t2 % ntn, tid);
                conv_store(cur, K, Bt, half, t / ntn, t % ntn, tile, tid);
                cur = nxt;
            }
        }
        cum += nt;
    }
    const int wid = tid >> 6, lane = tid & 63;
    bf16_t* XB = (bf16_t*)(p.ws + WS_XB); rs2_t* rs2 = (rs2_t*)(p.ws + WS_RS2);
    for (int row0 = blockIdx.x * 8 + wid; row0 < MT; row0 += G * 8 * 4) {
        f32x4 v[4][4];
#pragma unroll
        for (int r = 0; r < 4; ++r) { const int row = row0 + r * G * 8; const int rc = row < MT ? row : row0;
            const float* src = (rc < MP ? p.in[0] + (size_t)rc * DM : p.in[1] + (size_t)(rc - MP) * DM) + lane * 16;
#pragma unroll
            for (int i = 0; i < 4; ++i) v[r][i] = *(const f32x4*)(src + 4 * i); }
#pragma unroll
        for (int r = 0; r < 4; ++r) { const int row = row0 + r * G * 8;
            if (row < MT) {
                float ss = 0.f;
#pragma unroll
                for (int i = 0; i < 4; ++i) ss += (v[r][i][0] * v[r][i][0] + v[r][i][1] * v[r][i][1]) + (v[r][i][2] * v[r][i][2] + v[r][i][3] * v[r][i][3]);
                u32x4 w0, w1;
                w0.x = cvt_pk_bf16(v[r][0][0], v[r][0][1]); w0.y = cvt_pk_bf16(v[r][0][2], v[r][0][3]); w0.z = cvt_pk_bf16(v[r][1][0], v[r][1][1]); w0.w = cvt_pk_bf16(v[r][1][2], v[r][1][3]);
                w1.x = cvt_pk_bf16(v[r][2][0], v[r][2][1]); w1.y = cvt_pk_bf16(v[r][2][2], v[r][2][3]); w1.z = cvt_pk_bf16(v[r][3][0], v[r][3][1]); w1.w = cvt_pk_bf16(v[r][3][2], v[r][3][3]);
                bf16_t* xb = XB + (size_t)row * DM + lane * 16; *(u32x4*)xb = w0; *(u32x4*)(xb + 8) = w1;
#pragma unroll
                for (int o = 32; o >= 1; o >>= 1) ss += __shfl_xor(ss, o);
                if (lane < 9) rs2[(size_t)lane * MT + row] = lane == 0 ? (rs2_t)(ss * RS2_SCALE) : (rs2_t)0;
            }
        }
    }
}

typedef short bf16x4 __attribute__((ext_vector_type(4)));
typedef unsigned u32x2 __attribute__((ext_vector_type(2)));
union U2B4 { u32x2 u; bf16x4 b; };
union U4B8 { u32x4 u; bf16x8 b; };
struct SsmConst { bf16x8 Abu[8]; bf16x8 Ay[4]; f32x4 dsk, gn; };
__device__ __forceinline__ u32x2 ssm_load_u(const bf16_t* XB, const rs2_t* rs2, int row, int g, int q, const f32x4 gn) {
    const u32x2 x = *(const u32x2*)(XB + (size_t)row * DM + g * 16 + 4 * q);
    const float r = rsqrtf(rs2_to_float(rs2[row]) * RS2_INV + EPS);
    u32x2 o; o.x = cvt_pk_bf16(bf_lo(x.x) * gn[0] * r, bf_hi(x.x) * gn[1] * r); o.y = cvt_pk_bf16(bf_lo(x.y) * gn[2] * r, bf_hi(x.y) * gn[3] * r); return o;
}
__device__ __forceinline__ void ssm_update(f32x4 (&hr)[4], f32x4 (&hi)[4], const f32x4 (&lr)[4], const f32x4 (&li)[4], const SsmConst& C, const u32x2 ub) {
    U4B8 cv; cv.u = (u32x4){0u, 0u, ub.x, ub.y};
#pragma unroll
    for (int kk = 0; kk < 4; ++kk) {
        const f32x4 tr = lr[kk] * hr[kk] - li[kk] * hi[kk], ti = lr[kk] * hi[kk] + li[kk] * hr[kk];
        hr[kk] = __builtin_amdgcn_mfma_f32_16x16x32_bf16(C.Abu[2 * kk], cv.b, tr, 0, 0, 0);
        hi[kk] = __builtin_amdgcn_mfma_f32_16x16x32_bf16(C.Abu[2 * kk + 1], cv.b, ti, 0, 0, 0);
    }
}
__device__ __forceinline__ void ssm_update2(f32x4 (&hr)[4], f32x4 (&hi)[4], const f32x4 (&l2r)[4], const f32x4 (&l2i)[4], const SsmConst& C, const u32x2 u0, const u32x2 u1) {
    U4B8 cv; cv.u = (u32x4){u0.x, u0.y, u1.x, u1.y};
#pragma unroll
    for (int kk = 0; kk < 4; ++kk) {
        const f32x4 tr = l2r[kk] * hr[kk] - l2i[kk] * hi[kk], ti = l2r[kk] * hi[kk] + l2i[kk] * hr[kk];
        hr[kk] = __builtin_amdgcn_mfma_f32_16x16x32_bf16(C.Abu[2 * kk], cv.b, tr, 0, 0, 0);
        hi[kk] = __builtin_amdgcn_mfma_f32_16x16x32_bf16(C.Abu[2 * kk + 1], cv.b, ti, 0, 0, 0);
    }
}
__device__ __forceinline__ void ssm_emit(const f32x4 (&hr)[4], const f32x4 (&hi)[4], const SsmConst& C, const u32x2 ub, bf16_t* zp) {
    f32x4 y = (f32x4){0.f, 0.f, 0.f, 0.f};
#pragma unroll
    for (int s = 0; s < 4; ++s) { U4B8 hb; hb.u.x = cvt_pk_bf16(hr[s][0], hr[s][1]); hb.u.y = cvt_pk_bf16(hr[s][2], hr[s][3]); hb.u.z = cvt_pk_bf16(hi[s][0], hi[s][1]); hb.u.w = cvt_pk_bf16(hi[s][2], hi[s][3]);
        y = __builtin_amdgcn_mfma_f32_16x16x32_bf16(C.Ay[s], hb.b, y, 0, 0, 0); }
    const float u0 = bf_lo(ub.x), u1 = bf_hi(ub.x), u2 = bf_lo(ub.y), u3 = bf_hi(ub.y);
    const float z0 = gelu_tanh(y[0] + C.dsk[0] * u0), z1 = gelu_tanh(y[1] + C.dsk[1] * u1), z2 = gelu_tanh(y[2] + C.dsk[2] * u2), z3 = gelu_tanh(y[3] + C.dsk[3] * u3);
    u32x2 w; w.x = cvt_pk_bf16(z0, z1); w.y = cvt_pk_bf16(z2, z3); *(u32x2*)zp = w;
}
__device__ __forceinline__ void ssm_consts(KP& p, int layer, int j, int g, int n, int q, SsmConst& C, f32x4 (&lr)[4], f32x4 (&li)[4]) {
    const f32x4* SC = (const f32x4*)(p.ws + WS_SSMC) + (size_t)(j * 64 + g) * 64;
#pragma unroll
    for (int kk = 0; kk < 4; ++kk) {
#pragma unroll
        for (int jj = 0; jj < 4; ++jj) { const f32x4 c = SC[16 * kk + 4 * q + jj]; lr[kk][jj] = c[0]; li[kk][jj] = c[1]; }
        const f32x4 c = SC[16 * kk + n]; const float fre = c[2], fim = c[3];
        const size_t bo = ((size_t)(j * 64 + g) * 64 + 16 * kk + n) * 16 + 4 * q;
        const f32x4 br = *(const f32x4*)(p.in[11] + bo), bi = *(const f32x4*)(p.in[12] + bo);
        const f32x4 re = fre * br - fim * bi, im = fre * bi + fim * br;
        const f32x4 lre = c[0] * re - c[1] * im, lim = c[0] * im + c[1] * re;
        U4B8 a, b; a.u = (u32x4){cvt_pk_bf16(lre[0], lre[1]), cvt_pk_bf16(lre[2], lre[3]), cvt_pk_bf16(re[0], re[1]), cvt_pk_bf16(re[2], re[3])};
        b.u = (u32x4){cvt_pk_bf16(lim[0], lim[1]), cvt_pk_bf16(lim[2], lim[3]), cvt_pk_bf16(im[0], im[1]), cvt_pk_bf16(im[2], im[3])};
        C.Abu[2 * kk] = a.b; C.Abu[2 * kk + 1] = b.b;
        const size_t co = ((size_t)(j * 64 + g) * 16 + n) * 64 + 16 * kk + 4 * q;
        const f32x4 cr = *(const f32x4*)(p.in[13] + co), ci = *(const f32x4*)(p.in[14] + co);
        U4B8 ay; ay.u.x = cvt_pk_bf16(cr[0], cr[1]); ay.u.y = cvt_pk_bf16(cr[2], cr[3]); ay.u.z = cvt_pk_bf16(-ci[0], -ci[1]); ay.u.w = cvt_pk_bf16(-ci[2], -ci[3]);
        C.Ay[kk] = ay.b;
    }
    C.dsk = *(const f32x4*)(p.in[15] + j * 1024 + g * 16 + 4 * q);
    C.gn = *(const f32x4*)(p.in[6] + layer * 1024 + g * 16 + 4 * q);
}
template <int SHR> __device__ __forceinline__ float dpp_shr(float x) { return __int_as_float(__builtin_amdgcn_update_dpp(0, __float_as_int(x), 0x110 + SHR, 0xf, 0xf, true)); }
template <int SHR> __device__ __forceinline__ void scan_step(f32x4& Ir, f32x4& Ii, const f32x4 Pr, const f32x4 Pi) {
#pragma unroll
    for (int jj = 0; jj < 4; ++jj) { const float sr = dpp_shr<SHR>(Ir[jj]), si = dpp_shr<SHR>(Ii[jj]);
        Ir[jj] += Pr[jj] * sr - Pi[jj] * si; Ii[jj] += Pr[jj] * si + Pi[jj] * sr; }
}
__device__ __forceinline__ void csq(f32x4& Pr, f32x4& Pi) { const f32x4 r = Pr * Pr - Pi * Pi, i = 2.0f * Pr * Pi; Pr = r; Pi = i; }
__device__ __forceinline__ void cmul_sel(f32x4& Qr, f32x4& Qi, const f32x4 Pr, const f32x4 Pi, bool on) {
    const f32x4 r = Qr * Pr - Qi * Pi, i = Qr * Pi + Qi * Pr;
#pragma unroll
    for (int jj = 0; jj < 4; ++jj) { Qr[jj] = on ? r[jj] : Qr[jj]; Qi[jj] = on ? i[jj] : Qi[jj]; }
}
__device__ __forceinline__ void phase_ssm2(KP& p, int layer, unsigned char* shm) {
    int tid_ = threadIdx.x; asm volatile("" : "+v"(tid_));
    const int j = layer >> 1, tid = tid_, wid = tid >> 6, lane = tid & 63, n = lane & 15, q = lane >> 4, G = gridDim.x;
    const bf16_t* X = (const bf16_t*)(p.ws + WS_XB); const rs2_t* rss = (const rs2_t*)(p.ws + WS_RS2) + (size_t)(2 * layer) * MT; bf16_t* Z = (bf16_t*)(p.ws + WS_Z);
    u32x2* ubuf = (u32x2*)shm + wid * (32 * 64); float* tot = (float*)(shm + 131072);
    constexpr int T = 32;
    for (int it = blockIdx.x; it < 256; it += G) {
        const int idx = 2 * it + (wid >> 2), b = idx >> 6, g = idx & 63, wsub = wid & 3;
        SsmConst C; f32x4 lr[4], li[4], hr[4], hi[4];
        ssm_consts(p, layer, j, g, n, q, C, lr, li);
        const int row0 = b * SEQ + (16 * wsub + n) * T;
#pragma unroll
        for (int kk = 0; kk < 4; ++kk) { hr[kk] = (f32x4){0.f, 0.f, 0.f, 0.f}; hi[kk] = (f32x4){0.f, 0.f, 0.f, 0.f}; }
        {
            f32x4 l2r[4], l2i[4];
#pragma unroll
            for (int kk = 0; kk < 4; ++kk) { l2r[kk] = lr[kk] * lr[kk] - li[kk] * li[kk]; l2i[kk] = 2.0f * lr[kk] * li[kk]; }
#pragma unroll 1
            for (int t = 0; t < T; t += 2) { const u32x2 u0 = ssm_load_u(X, rss, row0 + t, g, q, C.gn), u1 = ssm_load_u(X, rss, row0 + t + 1, g, q, C.gn);
                ubuf[t * 64 + lane] = u0; ubuf[(t + 1) * 64 + lane] = u1; ssm_update2(hr, hi, l2r, l2i, C, u0, u1); }
        }
#pragma unroll
        for (int kk = 0; kk < 4; ++kk) {
            f32x4 Pr = lr[kk], Pi = li[kk];
#pragma unroll
            for (int i = 0; i < 5; ++i) csq(Pr, Pi);
            scan_step<1>(hr[kk], hi[kk], Pr, Pi); csq(Pr, Pi);
            scan_step<2>(hr[kk], hi[kk], Pr, Pi); csq(Pr, Pi);
            scan_step<4>(hr[kk], hi[kk], Pr, Pi); csq(Pr, Pi);
            scan_step<8>(hr[kk], hi[kk], Pr, Pi);
            __builtin_amdgcn_sched_barrier(0);
        }
        if (it != (int)blockIdx.x) __syncthreads();
        if (n == 15) {
#pragma unroll
            for (int kk = 0; kk < 4; ++kk) { *(f32x4*)(tot + wid * 128 + q * 32 + kk * 8) = hr[kk]; *(f32x4*)(tot + wid * 128 + q * 32 + kk * 8 + 4) = hi[kk]; }
        }
        __syncthreads();
#pragma unroll
        for (int kk = 0; kk < 4; ++kk) {
            f32x4 Pr = lr[kk], Pi = li[kk];
            asm volatile("" : "+v"(Pr), "+v"(Pi));
#pragma unroll
            for (int i = 0; i < 9; ++i) csq(Pr, Pi);
            f32x4 cr = (f32x4){0.f, 0.f, 0.f, 0.f}, ci = (f32x4){0.f, 0.f, 0.f, 0.f};
            for (int w2 = 0; w2 < wsub; ++w2) {
                const f32x4 tr = *(const f32x4*)(tot + ((wid & 4) + w2) * 128 + q * 32 + kk * 8), ti = *(const f32x4*)(tot + ((wid & 4) + w2) * 128 + q * 32 + kk * 8 + 4);
                const f32x4 nr = Pr * cr - Pi * ci + tr, ni = Pr * ci + Pi * cr + ti; cr = nr; ci = ni;
            }
            if (wsub == 3 && n == 15) {
                const size_t so = ((size_t)(j * 8 + b) * 64 + g) * 64 + 4 * q + 16 * kk;
                *(f32x4*)(p.out + O_PRE + so) = hr[kk] + Pr * cr - Pi * ci; *(f32x4*)(p.out + O_PIM + so) = hi[kk] + Pr * ci + Pi * cr;
            }
            asm volatile("" : "+v"(cr), "+v"(ci));
            f32x4 Rr = lr[kk], Ri = li[kk];
            asm volatile("" : "+v"(Rr), "+v"(Ri));
#pragma unroll
            for (int i = 0; i < 5; ++i) csq(Rr, Ri);
            cmul_sel(cr, ci, Rr, Ri, (n & 1) != 0); csq(Rr, Ri);
            cmul_sel(cr, ci, Rr, Ri, (n & 2) != 0); csq(Rr, Ri);
            cmul_sel(cr, ci, Rr, Ri, (n & 4) != 0); csq(Rr, Ri);
            cmul_sel(cr, ci, Rr, Ri, (n & 8) != 0);
#pragma unroll
            for (int jj = 0; jj < 4; ++jj) { hr[kk][jj] = dpp_shr<1>(hr[kk][jj]) + cr[jj]; hi[kk][jj] = dpp_shr<1>(hi[kk][jj]) + ci[jj]; }
            __builtin_amdgcn_sched_barrier(0);
        }
#pragma unroll 1
        for (int t = 0; t < T; ++t) { const u32x2 ub = ubuf[t * 64 + lane]; ssm_update(hr, hi, lr, li, C, ub); ssm_emit(hr, hi, C, ub, Z + (size_t)(row0 + t) * DM + g * 16 + 4 * q); }
    }
    for (int it = wid * G + blockIdx.x; it < 512; it += 8 * G) {
        const int g = it & 63, b = (it >> 6) * 16 + n;
        SsmConst C; f32x4 lr[4], li[4], hr[4], hi[4];
        ssm_consts(p, layer, j, g, n, q, C, lr, li);
        const size_t so = ((size_t)(j * 128 + b) * 64 + g) * 64 + 4 * q;
#pragma unroll
        for (int kk = 0; kk < 4; ++kk) { hr[kk] = *(const f32x4*)(p.in[2] + so + 16 * kk); hi[kk] = *(const f32x4*)(p.in[3] + so + 16 * kk); }
        const int row0 = MP + b * 8;
#pragma unroll 1
        for (int t = 0; t < 8; ++t) { const u32x2 ub = ssm_load_u(X, rss, row0 + t, g, q, C.gn); ssm_update(hr, hi, lr, li, C, ub); ssm_emit(hr, hi, C, ub, Z + (size_t)(row0 + t) * DM + g * 16 + 4 * q); }
#pragma unroll
        for (int kk = 0; kk < 4; ++kk) { *(f32x4*)(p.out + O_SRE + so + 16 * kk) = hr[kk]; *(f32x4*)(p.out + O_SIM + so + 16 * kk) = hi[kk]; }
    }
}

__device__ __forceinline__ void load_row64_bf16(const bf16_t* src, float* x) {
#pragma unroll
    for (int i = 0; i < 8; ++i) { const u32x4 w = *(const u32x4*)(src + i * 8);
        x[i * 8 + 0] = bf_lo(w.x); x[i * 8 + 1] = bf_hi(w.x); x[i * 8 + 2] = bf_lo(w.y); x[i * 8 + 3] = bf_hi(w.y);
        x[i * 8 + 4] = bf_lo(w.z); x[i * 8 + 5] = bf_hi(w.z); x[i * 8 + 6] = bf_lo(w.w); x[i * 8 + 7] = bf_hi(w.w); }
}
__device__ __forceinline__ void norm_rope_q(float* q, const float* gain, int pos, float scale) {
    float ss = 0.f;
#pragma unroll
    for (int d = 0; d < 64; ++d) ss += q[d] * q[d];
    const float r = rsqrtf(ss * (1.0f / 64.0f) + EPS);
#pragma unroll
    for (int d = 0; d < 64; ++d) q[d] = q[d] * r * gain[d];
#pragma unroll
    for (int i = 0; i < 8; ++i) { float c, s; rope_cs(pos, i, c, s); const float x1 = q[i], x2 = q[i + 8]; q[i] = x1 * c - x2 * s; q[i + 8] = x2 * c + x1 * s; }
#pragma unroll
    for (int d = 0; d < 64; ++d) q[d] *= scale;
}
__device__ __forceinline__ float gain_absmax(const float* g, int lane) {
    float m = fabsf(g[lane]);
#pragma unroll
    for (int o = 32; o >= 1; o >>= 1) m = fmaxf(m, __shfl_xor(m, o));
    return m; }

__device__ __forceinline__ void phase_attn(KP& p, int layer, unsigned char* shm) {
    int tid_ = threadIdx.x; asm volatile("" : "+v"(tid_));
    const int j = layer >> 1, tid = tid_, wid = tid >> 6, lane = tid & 63, G = gridDim.x;
    const bf16_t* QKV = (const bf16_t*)(p.ws + WS_QKV); bf16_t* O = (bf16_t*)(p.ws + WS_Z);
    const float* qg = p.in[18] + j * 64; const float* kg = p.in[19] + j * 64; const float* sinks = p.in[20] + j * 16;
    const float bound = 8.0f * gain_absmax(qg, lane) * gain_absmax(kg, lane);
    bf16_t* Kb = (bf16_t*)shm;
    bf16_t* Vt = (bf16_t*)(shm + 36864);
    const int n = lane & 15, kq = lane >> 4;
    constexpr float LOG2E = 1.4426950408889634f;
    for (int it = blockIdx.x; it < 512; it += G) {
        const int qb = it & 15, kvh = (it >> 4) & 3, b = it >> 6;
        __syncthreads();
        {
            const int row = tid >> 1, hf = tid & 1; const int kpos = qb * 128 - 128 + row;
            float kx[32];
            if (kpos >= 0) {
                const bf16_t* kp = QKV + (size_t)(b * SEQ + kpos) * NQKV + 1024 + kvh * 64 + hf * 32;
#pragma unroll
                for (int i = 0; i < 4; ++i) { const u32x4 w = *(const u32x4*)(kp + i * 8);
                    kx[i * 8 + 0] = bf_lo(w.x); kx[i * 8 + 1] = bf_hi(w.x); kx[i * 8 + 2] = bf_lo(w.y); kx[i * 8 + 3] = bf_hi(w.y); kx[i * 8 + 4] = bf_lo(w.z); kx[i * 8 + 5] = bf_hi(w.z); kx[i * 8 + 6] = bf_lo(w.w); kx[i * 8 + 7] = bf_hi(w.w); }
            } else {
#pragma unroll
                for (int d = 0; d < 32; ++d) kx[d] = 0.f;
            }
            float ss = 0.f;
#pragma unroll
            for (int d = 0; d < 32; ++d) ss += kx[d] * kx[d];
            ss += __shfl_xor(ss, 1);
            const float r = rsqrtf(ss * (1.0f / 64.0f) + EPS);
#pragma unroll
            for (int d4 = 0; d4 < 8; ++d4) { const f32x4 gv = *(const f32x4*)(kg + hf * 32 + 4 * d4); kx[4 * d4] *= r * gv[0]; kx[4 * d4 + 1] *= r * gv[1]; kx[4 * d4 + 2] *= r * gv[2]; kx[4 * d4 + 3] *= r * gv[3]; }
            if (hf == 0) {
#pragma unroll
                for (int i = 0; i < 8; ++i) { float c, s; rope_cs(kpos < 0 ? 0 : kpos, i, c, s); const float x1 = kx[i], x2 = kx[i + 8]; kx[i] = x1 * c - x2 * s; kx[i + 8] = x2 * c + x1 * s; }
            }
            bf16_t* kd = Kb + row * 72 + hf * 32;
#pragma unroll
            for (int i = 0; i < 4; ++i) { u32x4 w; w.x = cvt_pk_bf16(kx[8 * i], kx[8 * i + 1]); w.y = cvt_pk_bf16(kx[8 * i + 2], kx[8 * i + 3]); w.z = cvt_pk_bf16(kx[8 * i + 4], kx[8 * i + 5]); w.w = cvt_pk_bf16(kx[8 * i + 6], kx[8 * i + 7]); *(u32x4*)(kd + 8 * i) = w; }
            if (qb == 15 && row >= 128) {
                float* ck = p.out + O_PK + (((size_t)(j * 8 + b) * 128 + (row - 128)) * 4 + kvh) * 64 + hf * 32;
#pragma unroll
                for (int i = 0; i < 8; ++i) *(f32x4*)(ck + 4 * i) = (f32x4){kx[4 * i], kx[4 * i + 1], kx[4 * i + 2], kx[4 * i + 3]};
            }
        }
        {
            const int pr = tid >> 2, qd = tid & 3; const int kpos = qb * 128 - 128 + 2 * pr;
            u32x4 a0 = (u32x4){0u, 0u, 0u, 0u}, a1 = a0, b0 = a0, b1 = a0;
            if (kpos >= 0) { const bf16_t* vp = QKV + (size_t)(b * SEQ + kpos) * NQKV + 1280 + kvh * 64 + qd * 16;
                a0 = *(const u32x4*)vp; a1 = *(const u32x4*)(vp + 8); b0 = *(const u32x4*)(vp + NQKV); b1 = *(const u32x4*)(vp + NQKV + 8); }
            const unsigned av[8] = {a0.x, a0.y, a0.z, a0.w, a1.x, a1.y, a1.z, a1.w}, bv[8] = {b0.x, b0.y, b0.z, b0.w, b1.x, b1.y, b1.z, b1.w};
            unsigned* vt32 = (unsigned*)Vt;
#pragma unroll
            for (int i = 0; i < 8; ++i) {
                vt32[(qd * 16 + 2 * i) * 132 + pr] = (av[i] & 0xffffu) | (bv[i] << 16);
                vt32[(qd * 16 + 2 * i + 1) * 132 + pr] = (av[i] >> 16) | (bv[i] & 0xffff0000u);
            }
            if (qb == 15 && pr >= 64) {
                float* cv = p.out + O_PV + (((size_t)(j * 8 + b) * 128 + (2 * pr - 128)) * 4 + kvh) * 64 + qd * 16;
#pragma unroll
                for (int i = 0; i < 4; ++i) { *(f32x4*)(cv + 4 * i) = (f32x4){bf_lo(av[2 * i]), bf_hi(av[2 * i]), bf_lo(av[2 * i + 1]), bf_hi(av[2 * i + 1])};
                    *(f32x4*)(cv + 256 + 4 * i) = (f32x4){bf_lo(bv[2 * i]), bf_hi(bv[2 * i]), bf_lo(bv[2 * i + 1]), bf_hi(bv[2 * i + 1])}; }
            }
        }
        __syncthreads();
        {
            const int r = wid >> 1, w0 = (wid & 1) * 64, h = kvh * 4 + r;
            const float sk = sinks[h]; const float mh2 = fmaxf(bound, sk) * LOG2E;
            bf16x8 Qf[4][2];
#pragma unroll
            for (int qt = 0; qt < 4; ++qt) {
                const int qpos = qb * 128 + w0 + 16 * qt + n;
                const bf16_t* src = QKV + (size_t)(b * SEQ + qpos) * NQKV + h * 64 + 8 * kq;
                const u32x4 wa = *(const u32x4*)src, wb = *(const u32x4*)(src + 32);
                float x0[8] = {bf_lo(wa.x), bf_hi(wa.x), bf_lo(wa.y), bf_hi(wa.y), bf_lo(wa.z), bf_hi(wa.z), bf_lo(wa.w), bf_hi(wa.w)};
                float x1[8] = {bf_lo(wb.x), bf_hi(wb.x), bf_lo(wb.y), bf_hi(wb.y), bf_lo(wb.z), bf_hi(wb.z), bf_lo(wb.w), bf_hi(wb.w)};
                float ss = 0.f;
#pragma unroll
                for (int e = 0; e < 8; ++e) ss += x0[e] * x0[e] + x1[e] * x1[e];
                ss += __shfl_xor(ss, 16); ss += __shfl_xor(ss, 32);
                const float rr = rsqrtf(ss * (1.0f / 64.0f) + EPS);
                float ot[8];
#pragma unroll
                for (int e4 = 0; e4 < 2; ++e4) { const f32x4 ga = *(const f32x4*)(qg + 8 * kq + 4 * e4), gb = *(const f32x4*)(qg + 32 + 8 * kq + 4 * e4);
#pragma unroll
                    for (int e = 0; e < 4; ++e) { x0[4 * e4 + e] = x0[4 * e4 + e] * rr * ga[e]; x1[4 * e4 + e] = x1[4 * e4 + e] * rr * gb[e]; } }
#pragma unroll
                for (int e = 0; e < 8; ++e) ot[e] = __shfl_xor(x0[e], 16);
                if (kq < 2) {
#pragma unroll
                    for (int e = 0; e < 8; ++e) { float c, s; rope_cs(qpos, e, c, s); x0[e] = (kq == 0) ? (x0[e] * c - ot[e] * s) : (x0[e] * c + ot[e] * s); }
                }
                const float sc = 0.125f * LOG2E;
                U4B8 f0, f1;
                f0.u.x = cvt_pk_bf16(x0[0] * sc, x0[1] * sc); f0.u.y = cvt_pk_bf16(x0[2] * sc, x0[3] * sc); f0.u.z = cvt_pk_bf16(x0[4] * sc, x0[5] * sc); f0.u.w = cvt_pk_bf16(x0[6] * sc, x0[7] * sc);
                f1.u.x = cvt_pk_bf16(x1[0] * sc, x1[1] * sc); f1.u.y = cvt_pk_bf16(x1[2] * sc, x1[3] * sc); f1.u.z = cvt_pk_bf16(x1[4] * sc, x1[5] * sc); f1.u.w = cvt_pk_bf16(x1[6] * sc, x1[7] * sc);
                Qf[qt][0] = f0.b; Qf[qt][1] = f1.b;
            }
            f32x4 Oa[4][4]; float lsum[4];
#pragma unroll
            for (int dt = 0; dt < 4; ++dt)
#pragma unroll
                for (int qt = 0; qt < 4; ++qt) Oa[dt][qt] = (f32x4){0.f, 0.f, 0.f, 0.f};
#pragma unroll
            for (int qt = 0; qt < 4; ++qt) lsum[qt] = 0.f;
            for (int st = 0; st < 6; ++st) {
                const int k0 = w0 + 32 * st;
                if (qb == 0 && k0 + 31 < 128) continue;
                bf16x8 Ka[2][2], Va[4];
#pragma unroll
                for (int kt = 0; kt < 2; ++kt)
#pragma unroll
                    for (int ks = 0; ks < 2; ++ks) Ka[kt][ks] = *(const bf16x8*)(Kb + (k0 + 16 * kt + n) * 72 + ks * 32 + kq * 8);
#pragma unroll
                for (int dt = 0; dt < 4; ++dt) { const u32x2 lo = *(const u32x2*)(Vt + (16 * dt + n) * 264 + k0 + 4 * kq), hi = *(const u32x2*)(Vt + (16 * dt + n) * 264 + k0 + 16 + 4 * kq);
                    U4B8 v; v.u.x = lo.x; v.u.y = lo.y; v.u.z = hi.x; v.u.w = hi.y; Va[dt] = v.b; }
#pragma unroll
                for (int qt = 0; qt < 4; ++qt) {
                    const int qlo = w0 + 16 * qt;
                    if (k0 + 31 < qlo + 1 || k0 > qlo + 143) continue;
                    f32x4 S0 = (f32x4){0.f, 0.f, 0.f, 0.f}, S1 = S0;
                    S0 = __builtin_amdgcn_mfma_f32_16x16x32_bf16(Ka[0][0], Qf[qt][0], S0, 0, 0, 0); S0 = __builtin_amdgcn_mfma_f32_16x16x32_bf16(Ka[0][1], Qf[qt][1], S0, 0, 0, 0);
                    S1 = __builtin_amdgcn_mfma_f32_16x16x32_bf16(Ka[1][0], Qf[qt][0], S1, 0, 0, 0); S1 = __builtin_amdgcn_mfma_f32_16x16x32_bf16(Ka[1][1], Qf[qt][1], S1, 0, 0, 0);
                    float pa[4], pb[4]; float ls = 0.f;
                    const int rel = k0 - qlo;
                    if (rel >= 16 && rel + 31 <= 128 && (qb > 0 || k0 >= 128)) {
#pragma unroll
                        for (int jj = 0; jj < 4; ++jj) { pa[jj] = __builtin_amdgcn_exp2f(S0[jj] - mh2); pb[jj] = __builtin_amdgcn_exp2f(S1[jj] - mh2); ls += pa[jj] + pb[jj]; }
                    } else {
                        const int ql = qlo + n, lo = max(ql + 1, qb == 0 ? 128 : 0);
                        const unsigned span = (unsigned)(ql + 128 - lo); const int ka0 = k0 + 4 * kq - lo;
#pragma unroll
                        for (int jj = 0; jj < 4; ++jj) { const bool va = (unsigned)(ka0 + jj) <= span, vb = (unsigned)(ka0 + 16 + jj) <= span;
                            pa[jj] = va ? __builtin_amdgcn_exp2f(S0[jj] - mh2) : 0.f; pb[jj] = vb ? __builtin_amdgcn_exp2f(S1[jj] - mh2) : 0.f; ls += pa[jj] + pb[jj]; }
                    }
                    lsum[qt] += ls;
                    U4B8 pk; pk.u.x = cvt_pk_bf16(pa[0], pa[1]); pk.u.y = cvt_pk_bf16(pa[2], pa[3]); pk.u.z = cvt_pk_bf16(pb[0], pb[1]); pk.u.w = cvt_pk_bf16(pb[2], pb[3]);
#pragma unroll
                    for (int dt = 0; dt < 4; ++dt) Oa[dt][qt] = __builtin_amdgcn_mfma_f32_16x16x32_bf16(Va[dt], pk.b, Oa[dt][qt], 0, 0, 0);
                }
            }
            const float esink = __builtin_amdgcn_exp2f(sk * LOG2E - mh2);
#pragma unroll
            for (int qt = 0; qt < 4; ++qt) {
                float l = lsum[qt]; l += __shfl_xor(l, 16); l += __shfl_xor(l, 32);
                const float inv = 1.0f / (l + esink);
                const int qpos = qb * 128 + w0 + 16 * qt + n;
                bf16_t* orow = O + (size_t)(b * SEQ + qpos) * DM + h * 64;
                u32x2 w[4];
#pragma unroll
                for (int dt = 0; dt < 4; ++dt) { const f32x4 o = Oa[dt][qt] * inv; w[dt].x = cvt_pk_bf16(o[0], o[1]); w[dt].y = cvt_pk_bf16(o[2], o[3]); }
                const bool odd = (kq & 1) != 0;
#pragma unroll
                for (int pr2 = 0; pr2 < 2; ++pr2) {
                    const u32x2 own_keep = odd ? w[2 * pr2 + 1] : w[2 * pr2], send = odd ? w[2 * pr2] : w[2 * pr2 + 1];
                    u32x2 recv; recv.x = (unsigned)__shfl_xor((int)send.x, 16); recv.y = (unsigned)__shfl_xor((int)send.y, 16);
                    u32x4 st; st.x = odd ? recv.x : own_keep.x; st.y = odd ? recv.y : own_keep.y; st.z = odd ? own_keep.x : recv.x; st.w = odd ? own_keep.y : recv.y;
                    *(u32x4*)(orow + 16 * (2 * pr2 + (odd ? 1 : 0)) + 4 * (kq & ~1)) = st;
                }
            }
        }
    }
    const float* ck_in = p.in[4]; const float* cv_in = p.in[5];
    for (int it = blockIdx.x; it < 512; it += G) {
        const int b = it >> 2, kvh = it & 3;
        __syncthreads();
        const int vpr = tid >> 3, vod = tid & 7;
        const size_t vso = (((size_t)(j * 128 + b) * 128 + 2 * vpr) * 4 + kvh) * 64 + vod * 8;
        const f32x4 va0 = *(const f32x4*)(cv_in + vso), va1 = *(const f32x4*)(cv_in + vso + 4), vb0 = *(const f32x4*)(cv_in + vso + 256), vb1 = *(const f32x4*)(cv_in + vso + 260);
        {
            const int row = tid >> 2, part = tid & 3;
            const size_t so = (((size_t)(j * 128 + b) * 128 + row) * 4 + kvh) * 64 + part * 16;
            const f32x4 v0 = *(const f32x4*)(ck_in + so), v1 = *(const f32x4*)(ck_in + so + 4), v2 = *(const f32x4*)(ck_in + so + 8), v3 = *(const f32x4*)(ck_in + so + 12);
            u32x4 w0, w1; w0.x = cvt_pk_bf16(v0[0], v0[1]); w0.y = cvt_pk_bf16(v0[2], v0[3]); w0.z = cvt_pk_bf16(v1[0], v1[1]); w0.w = cvt_pk_bf16(v1[2], v1[3]);
            w1.x = cvt_pk_bf16(v2[0], v2[1]); w1.y = cvt_pk_bf16(v2[2], v2[3]); w1.z = cvt_pk_bf16(v3[0], v3[1]); w1.w = cvt_pk_bf16(v3[2], v3[3]);
            *(u32x4*)(Kb + row * 72 + part * 16) = w0; *(u32x4*)(Kb + row * 72 + part * 16 + 8) = w1;
        }
        {
            const int pr = vpr, od = vod; const size_t so = vso;
            const f32x4 a0 = va0, a1 = va1, b0 = vb0, b1 = vb1;
            unsigned* vt32 = (unsigned*)Vt;
#pragma unroll
            for (int i = 0; i < 4; ++i) { vt32[(od * 8 + i) * 132 + pr] = cvt_pk_bf16(a0[i], b0[i]); vt32[(od * 8 + 4 + i) * 132 + pr] = cvt_pk_bf16(a1[i], b1[i]); }
        }
        if (wid == 2) {
            const int jn = lane >> 3, part = lane & 7; const int tok = MP + b * 8 + jn;
            const bf16_t* kp = QKV + (size_t)tok * NQKV + 1024 + kvh * 64 + part * 8;
            const u32x4 w = *(const u32x4*)kp;
            float kx[8] = {bf_lo(w.x), bf_hi(w.x), bf_lo(w.y), bf_hi(w.y), bf_lo(w.z), bf_hi(w.z), bf_lo(w.w), bf_hi(w.w)};
            float ss = 0.f;
#pragma unroll
            for (int e = 0; e < 8; ++e) ss += kx[e] * kx[e];
            ss += __shfl_xor(ss, 1); ss += __shfl_xor(ss, 2); ss += __shfl_xor(ss, 4);
            const float r = rsqrtf(ss * (1.0f / 64.0f) + EPS);
            float ot[8];
#pragma unroll
            for (int e4 = 0; e4 < 2; ++e4) { const f32x4 gv = *(const f32x4*)(kg + part * 8 + 4 * e4); kx[4 * e4] *= r * gv[0]; kx[4 * e4 + 1] *= r * gv[1]; kx[4 * e4 + 2] *= r * gv[2]; kx[4 * e4 + 3] *= r * gv[3]; }
#pragma unroll
            for (int e = 0; e < 8; ++e) ot[e] = __shfl_xor(kx[e], 1);
            if (part < 2) {
#pragma unroll
                for (int e = 0; e < 8; ++e) { float c, s; rope_cs(PAST + jn, e, c, s); kx[e] = (part == 0) ? (kx[e] * c - ot[e] * s) : (kx[e] * c + ot[e] * s); }
            }
            u32x4 wk; wk.x = cvt_pk_bf16(kx[0], kx[1]); wk.y = cvt_pk_bf16(kx[2], kx[3]); wk.z = cvt_pk_bf16(kx[4], kx[5]); wk.w = cvt_pk_bf16(kx[6], kx[7]);
            *(u32x4*)(Kb + (128 + jn) * 72 + part * 8) = wk;
            float* ck = p.out + O_SK + (((size_t)(j * 128 + b) * 128 + (120 + jn)) * 4 + kvh) * 64 + part * 8;
            *(f32x4*)ck = (f32x4){kx[0], kx[1], kx[2], kx[3]}; *(f32x4*)(ck + 4) = (f32x4){kx[4], kx[5], kx[6], kx[7]};
        }
        if (wid == 3) {
            const int pr = lane >> 3, od = lane & 7;
            unsigned* vt32 = (unsigned*)Vt;
            if (pr < 4) {
                const bf16_t* vp = QKV + (size_t)(MP + b * 8 + 2 * pr) * NQKV + 1280 + kvh * 64 + od * 8;
                const u32x4 a = *(const u32x4*)vp, bq = *(const u32x4*)(vp + NQKV);
                const unsigned av[4] = {a.x, a.y, a.z, a.w}, bv[4] = {bq.x, bq.y, bq.z, bq.w};
#pragma unroll
                for (int i = 0; i < 4; ++i) { vt32[(od * 8 + 2 * i) * 132 + 64 + pr] = (av[i] & 0xffffu) | (bv[i] << 16); vt32[(od * 8 + 2 * i + 1) * 132 + 64 + pr] = (av[i] >> 16) | (bv[i] & 0xffff0000u); }
                float* cv = p.out + O_SV + (((size_t)(j * 128 + b) * 128 + (120 + 2 * pr)) * 4 + kvh) * 64 + od * 8;
                *(f32x4*)cv = (f32x4){bf_lo(av[0]), bf_hi(av[0]), bf_lo(av[1]), bf_hi(av[1])}; *(f32x4*)(cv + 4) = (f32x4){bf_lo(av[2]), bf_hi(av[2]), bf_lo(av[3]), bf_hi(av[3])};
                *(f32x4*)(cv + 256) = (f32x4){bf_lo(bv[0]), bf_hi(bv[0]), bf_lo(bv[1]), bf_hi(bv[1])}; *(f32x4*)(cv + 260) = (f32x4){bf_lo(bv[2]), bf_hi(bv[2]), bf_lo(bv[3]), bf_hi(bv[3])};
            }
            for (int i = lane; i < 64 * 12; i += 64) vt32[(i / 12) * 132 + 68 + (i % 12)] = 0u;
            for (int i = lane; i < 24 * 8; i += 64) *(u32x4*)(Kb + (136 + i / 8) * 72 + (i % 8) * 8) = (u32x4){0u, 0u, 0u, 0u};
        }
        __syncthreads();
        if (wid < 2) {
            const int qt = wid, pair = 16 * qt + n, qi = pair >> 2, r = pair & 3, h = kvh * 4 + r; const int tok = MP + b * 8 + qi;
            const float sk = sinks[h]; const float mh2 = fmaxf(bound, sk) * LOG2E;
            bf16x8 Qf[2];
            {
                const bf16_t* src = QKV + (size_t)tok * NQKV + h * 64 + 8 * kq;
                const u32x4 wa = *(const u32x4*)src, wb = *(const u32x4*)(src + 32);
                float x0[8] = {bf_lo(wa.x), bf_hi(wa.x), bf_lo(wa.y), bf_hi(wa.y), bf_lo(wa.z), bf_hi(wa.z), bf_lo(wa.w), bf_hi(wa.w)};
                float x1[8] = {bf_lo(wb.x), bf_hi(wb.x), bf_lo(wb.y), bf_hi(wb.y), bf_lo(wb.z), bf_hi(wb.z), bf_lo(wb.w), bf_hi(wb.w)};
                float ss = 0.f;
#pragma unroll
                for (int e = 0; e < 8; ++e) ss += x0[e] * x0[e] + x1[e] * x1[e];
                ss += __shfl_xor(ss, 16); ss += __shfl_xor(ss, 32);
                const float rr = rsqrtf(ss * (1.0f / 64.0f) + EPS);
                float ot[8];
#pragma unroll
                for (int e4 = 0; e4 < 2; ++e4) { const f32x4 ga = *(const f32x4*)(qg + 8 * kq + 4 * e4), gb = *(const f32x4*)(qg + 32 + 8 * kq + 4 * e4);
#pragma unroll
                    for (int e = 0; e < 4; ++e) { x0[4 * e4 + e] = x0[4 * e4 + e] * rr * ga[e]; x1[4 * e4 + e] = x1[4 * e4 + e] * rr * gb[e]; } }
#pragma unroll
                for (int e = 0; e < 8; ++e) ot[e] = __shfl_xor(x0[e], 16);
                if (kq < 2) {
#pragma unroll
                    for (int e = 0; e < 8; ++e) { float c, s; rope_cs(PAST + qi, e, c, s); x0[e] = (kq == 0) ? (x0[e] * c - ot[e] * s) : (x0[e] * c + ot[e] * s); }
                }
                const float sc = 0.125f * LOG2E;
                U4B8 f0, f1;
                f0.u.x = cvt_pk_bf16(x0[0] * sc, x0[1] * sc); f0.u.y = cvt_pk_bf16(x0[2] * sc, x0[3] * sc); f0.u.z = cvt_pk_bf16(x0[4] * sc, x0[5] * sc); f0.u.w = cvt_pk_bf16(x0[6] * sc, x0[7] * sc);
                f1.u.x = cvt_pk_bf16(x1[0] * sc, x1[1] * sc); f1.u.y = cvt_pk_bf16(x1[2] * sc, x1[3] * sc); f1.u.z = cvt_pk_bf16(x1[4] * sc, x1[5] * sc); f1.u.w = cvt_pk_bf16(x1[6] * sc, x1[7] * sc);
                Qf[0] = f0.b; Qf[1] = f1.b;
            }
            f32x4 Oa[4]; float lsum = 0.f;
#pragma unroll
            for (int dt = 0; dt < 4; ++dt) Oa[dt] = (f32x4){0.f, 0.f, 0.f, 0.f};
#pragma unroll
            for (int st = 0; st < 5; ++st) {
                const int k0 = 32 * st;
                bf16x8 Ka[2][2], Va[4];
#pragma unroll
                for (int kt = 0; kt < 2; ++kt)
#pragma unroll
                    for (int ks = 0; ks < 2; ++ks) Ka[kt][ks] = *(const bf16x8*)(Kb + (k0 + 16 * kt + n) * 72 + ks * 32 + kq * 8);
#pragma unroll
                for (int dt = 0; dt < 4; ++dt) { const u32x2 lo = *(const u32x2*)(Vt + (16 * dt + n) * 264 + k0 + 4 * kq), hi = *(const u32x2*)(Vt + (16 * dt + n) * 264 + k0 + 16 + 4 * kq);
                    U4B8 v; v.u.x = lo.x; v.u.y = lo.y; v.u.z = hi.x; v.u.w = hi.y; Va[dt] = v.b; }
                f32x4 S0 = (f32x4){0.f, 0.f, 0.f, 0.f}, S1 = S0;
                S0 = __builtin_amdgcn_mfma_f32_16x16x32_bf16(Ka[0][0], Qf[0], S0, 0, 0, 0); S0 = __builtin_amdgcn_mfma_f32_16x16x32_bf16(Ka[0][1], Qf[1], S0, 0, 0, 0);
                S1 = __builtin_amdgcn_mfma_f32_16x16x32_bf16(Ka[1][0], Qf[0], S1, 0, 0, 0); S1 = __builtin_amdgcn_mfma_f32_16x16x32_bf16(Ka[1][1], Qf[1], S1, 0, 0, 0);
                float pa[4], pb[4];
                if (st >= 1 && st <= 3) {
#pragma unroll
                    for (int jj = 0; jj < 4; ++jj) { pa[jj] = __builtin_amdgcn_exp2f(S0[jj] - mh2); pb[jj] = __builtin_amdgcn_exp2f(S1[jj] - mh2); lsum += pa[jj] + pb[jj]; }
                } else {
                    const int ka0 = k0 + 4 * kq - (qi + 1);
#pragma unroll
                    for (int jj = 0; jj < 4; ++jj) { const bool va = (unsigned)(ka0 + jj) <= 127u, vb = (unsigned)(ka0 + 16 + jj) <= 127u;
                        pa[jj] = va ? __builtin_amdgcn_exp2f(S0[jj] - mh2) : 0.f; pb[jj] = vb ? __builtin_amdgcn_exp2f(S1[jj] - mh2) : 0.f; lsum += pa[jj] + pb[jj]; }
                }
                U4B8 pk; pk.u.x = cvt_pk_bf16(pa[0], pa[1]); pk.u.y = cvt_pk_bf16(pa[2], pa[3]); pk.u.z = cvt_pk_bf16(pb[0], pb[1]); pk.u.w = cvt_pk_bf16(pb[2], pb[3]);
#pragma unroll
                for (int dt = 0; dt < 4; ++dt) Oa[dt] = __builtin_amdgcn_mfma_f32_16x16x32_bf16(Va[dt], pk.b, Oa[dt], 0, 0, 0);
            }
            lsum += __shfl_xor(lsum, 16); lsum += __shfl_xor(lsum, 32);
            const float inv = 1.0f / (lsum + __builtin_amdgcn_exp2f(sk * LOG2E - mh2));
            bf16_t* orow = O + (size_t)tok * DM + h * 64;
            u32x2 w[4];
#pragma unroll
            for (int dt = 0; dt < 4; ++dt) { const f32x4 o = Oa[dt] * inv; w[dt].x = cvt_pk_bf16(o[0], o[1]); w[dt].y = cvt_pk_bf16(o[2], o[3]); }
            const bool odd = (kq & 1) != 0;
#pragma unroll
            for (int pr2 = 0; pr2 < 2; ++pr2) {
                const u32x2 own_keep = odd ? w[2 * pr2 + 1] : w[2 * pr2], send = odd ? w[2 * pr2] : w[2 * pr2 + 1];
                u32x2 recv; recv.x = (unsigned)__shfl_xor((int)send.x, 16); recv.y = (unsigned)__shfl_xor((int)send.y, 16);
                u32x4 st; st.x = odd ? recv.x : own_keep.x; st.y = odd ? recv.y : own_keep.y; st.z = odd ? own_keep.x : recv.x; st.w = odd ? own_keep.y : recv.y;
                *(u32x4*)(orow + 16 * (2 * pr2 + (odd ? 1 : 0)) + 4 * (kq & ~1)) = st;
            }
        }
    }
}

template <bool GLU>
__device__ __forceinline__ void sgemm_tile(const bf16_t* A, const bf16_t* Bt, int K, float* X, bf16_t* XB, rs2_t* rs2, float* lds) {
    int tid_ = threadIdx.x; asm volatile("" : "+v"(tid_));
    const int tid = tid_, wid = tid >> 6, lane = tid & 63, n = lane & 15, kq = lane >> 4;
    constexpr int NCT = GLU ? 32 : 16, CW = GLU ? 32 : 64, NT = 16 * NCT;
    const int kbase = wid * (K >> 3), nsteps = K >> 8;
    for (int t = blockIdx.x; t < NT; t += gridDim.x) {
        const int rt0 = (t / NCT) * 64, ct0 = (t % NCT) * CW;
        const bf16_t* ap[4]; const bf16_t* bp[4];
#pragma unroll
        for (int r = 0; r < 4; ++r) ap[r] = A + (size_t)(MP + rt0 + 16 * r + n) * K + kbase + 8 * kq;
#pragma unroll
        for (int c = 0; c < 4; ++c) { int brow;
            if (GLU) { const int col = ct0 + 16 * (c & 1) + n; brow = (col >> 7) * 256 + (col & 127) + (c >> 1) * 128; }
            else brow = ct0 + 16 * c + n;
            bp[c] = Bt + (size_t)brow * K + kbase + 8 * kq; }
        f32x4 acc[4][4];
#pragma unroll
        for (int r = 0; r < 4; ++r)
#pragma unroll
            for (int c = 0; c < 4; ++c) acc[r][c] = (f32x4){0.f, 0.f, 0.f, 0.f};
        for (int s0 = 0; s0 < nsteps; s0 += 4) {
            bf16x8 af[4][4], bf[4][4];
#pragma unroll
            for (int u = 0; u < 4; ++u) { const int st = (s0 + u < nsteps) ? s0 + u : nsteps - 1;
#pragma unroll
                for (int r = 0; r < 4; ++r) af[u][r] = *(const bf16x8*)(ap[r] + 32 * st);
#pragma unroll
                for (int c = 0; c < 4; ++c) bf[u][c] = *(const bf16x8*)(bp[c] + 32 * st); }
#pragma unroll
            for (int u = 0; u < 4; ++u) { if (s0 + u < nsteps) {
#pragma unroll
                for (int r = 0; r < 4; ++r)
#pragma unroll
                    for (int c = 0; c < 4; ++c) acc[r][c] = __builtin_amdgcn_mfma_f32_16x16x32_bf16(bf[u][c], af[u][r], acc[r][c], 0, 0, 0); } }
        }
        __syncthreads();
#pragma unroll
        for (int r = 0; r < 4; ++r)
#pragma unroll
            for (int c = 0; c < 4; ++c) *(f32x4*)(lds + wid * 4096 + (16 * r + n) * 64 + 16 * c + 4 * kq) = acc[r][c];
        __syncthreads();
        const int row = MP + rt0 + (tid >> 3);
        const float* lp = lds + (tid >> 3) * 64;
        float ss = 0.f;
        if (GLU) {
            const int c4 = (tid & 7) * 4; f32x4 av = (f32x4){0.f, 0.f, 0.f, 0.f}, gv = av;
#pragma unroll
            for (int w = 0; w < 8; ++w) { av += *(const f32x4*)(lp + w * 4096 + c4); gv += *(const f32x4*)(lp + w * 4096 + 32 + c4); }
            f32x4 d;
#pragma unroll
            for (int jj = 0; jj < 4; ++jj) d[jj] = av[jj] * sigmoidf_(gv[jj]);
            const u32x2 xo = *(const u32x2*)(XB + (size_t)row * DM + ct0 + c4);
            const f32x4 x0 = (f32x4){bf_lo(xo.x), bf_hi(xo.x), bf_lo(xo.y), bf_hi(xo.y)} + d;
            if (X) *(f32x4*)(X + (size_t)row * DM + ct0 + c4) = x0;
            u32x2 w2; w2.x = cvt_pk_bf16(x0[0], x0[1]); w2.y = cvt_pk_bf16(x0[2], x0[3]); *(u32x2*)(XB + (size_t)row * DM + ct0 + c4) = w2;
            ss = (x0[0] * x0[0] + x0[1] * x0[1]) + (x0[2] * x0[2] + x0[3] * x0[3]);
        } else {
            const int c8 = (tid & 7) * 8; f32x4 d0 = (f32x4){0.f, 0.f, 0.f, 0.f}, d1 = d0;
#pragma unroll
            for (int w = 0; w < 8; ++w) { d0 += *(const f32x4*)(lp + w * 4096 + c8); d1 += *(const f32x4*)(lp + w * 4096 + c8 + 4); }
            const u32x4 xo = *(const u32x4*)(XB + (size_t)row * DM + ct0 + c8);
            const f32x4 x0 = (f32x4){bf_lo(xo.x), bf_hi(xo.x), bf_lo(xo.y), bf_hi(xo.y)} + d0, x1 = (f32x4){bf_lo(xo.z), bf_hi(xo.z), bf_lo(xo.w), bf_hi(xo.w)} + d1;
            if (X) { float* xp = X + (size_t)row * DM + ct0 + c8; *(f32x4*)xp = x0; *(f32x4*)(xp + 4) = x1; continue; }
            u32x4 w4; w4.x = cvt_pk_bf16(x0[0], x0[1]); w4.y = cvt_pk_bf16(x0[2], x0[3]); w4.z = cvt_pk_bf16(x1[0], x1[1]); w4.w = cvt_pk_bf16(x1[2], x1[3]);
            *(u32x4*)(XB + (size_t)row * DM + ct0 + c8) = w4;
            ss = ((x0[0] * x0[0] + x0[1] * x0[1]) + (x0[2] * x0[2] + x0[3] * x0[3])) + ((x1[0] * x1[0] + x1[1] * x1[1]) + (x1[2] * x1[2] + x1[3] * x1[3]));
        }
        ss += __shfl_xor(ss, 1); ss += __shfl_xor(ss, 2); ss += __shfl_xor(ss, 4);
        if ((tid & 7) == 0) atomicAdd(rs2 + row, (rs2_t)(ss * RS2_SCALE));
    }
}

__device__ __forceinline__ void cache_shift_copy(KP& p, int j, int ic, int nic) {
    int tid_ = threadIdx.x; asm volatile("" : "+v"(tid_)); const int tid = tid_;
    for (int r = ic; r < 256; r += nic) {
        const int kv = r >> 7, b = r & 127;
        const f32x4* src = (const f32x4*)((kv ? p.in[5] : p.in[4]) + ((size_t)(j * 128 + b) * 128 + 8) * 256);
        f32x4* dst = (f32x4*)(p.out + (kv ? O_SV : O_SK) + ((size_t)(j * 128 + b) * 128) * 256);
        f32x4 v[15];
#pragma unroll
        for (int i = 0; i < 15; ++i) v[i] = src[i * 512 + tid];
#pragma unroll
        for (int i = 0; i < 15; ++i) dst[i * 512 + tid] = v[i];
    }
}

#define XB_TMO      128
#define XB_XCNT(j)  (256  + 64 * (j))
#define XB_XSUB(j)  (1280 + 64 * (j))
#define XB_XGEN(j)  (2304 + 64 * (j))
#define XB_TOP      3328
#define XB_TOPGEN   3392
#define XCD_BAR_WORDS 3456
#define XB_SPIN_CAP (1u << 18)
__device__ __forceinline__ unsigned xb_ld(unsigned* p)              { return __hip_atomic_load(p, __ATOMIC_RELAXED, __HIP_MEMORY_SCOPE_AGENT); }
__device__ __forceinline__ unsigned xb_add(unsigned* p, unsigned v) { return __hip_atomic_fetch_add(p, v, __ATOMIC_RELAXED, __HIP_MEMORY_SCOPE_AGENT); }
__device__ __forceinline__ unsigned xb_xcc_id() { return (unsigned)__builtin_amdgcn_s_getreg((3 << 11) | 20) & 0xFu; }
#define XB_SPIN(cond, bar) do { unsigned _sp = 0; while (cond) { __builtin_amdgcn_s_sleep(1); \
    if ((++_sp & 255u) == 0u) { if (xb_ld(&(bar)[XB_TMO])) break; if (_sp > XB_SPIN_CAP) { atomicAdd(&(bar)[XB_TMO], 1u); break; } } } } while (0)
struct XcdBarrier { unsigned* bar; unsigned x; volatile LAS unsigned* st; };
__device__ __forceinline__ XcdBarrier xcd_barrier_post(unsigned* bar, volatile LAS unsigned* st) {
    XcdBarrier b; b.bar = bar; b.x = xb_xcc_id(); b.st = st;
    if (threadIdx.x == 0) (void)xb_add(&bar[XB_XCNT(b.x)], 1u);
    return b;
}
__device__ __forceinline__ void xcd_barrier_complete(unsigned* bar, unsigned x, unsigned& nloc, unsigned& nx) {
    const unsigned G = gridDim.x * gridDim.y * gridDim.z;
    unsigned sum, cnt, mine, sp = 0u;
    for (;;) {
        sum = 0u; cnt = 0u; mine = 0u;
#pragma unroll
        for (unsigned j = 0; j < 16; ++j) { const unsigned c = xb_ld(&bar[XB_XCNT(j)]); sum += c; cnt += (c > 0u) ? 1u : 0u; mine = (j == x) ? c : mine; }
        if (sum == G) break;
        __builtin_amdgcn_s_sleep(1);
        if ((++sp & 255u) == 0u) { if (xb_ld(&bar[XB_TMO])) break; if (sp > XB_SPIN_CAP) { atomicAdd(&bar[XB_TMO], 1u); break; } }
    }
    nloc = mine > 0u ? mine : 1u; nx = cnt > 0u ? cnt : 1u;
}
__device__ __forceinline__ void xcd_barrier(const XcdBarrier& b) {
    asm volatile("s_waitcnt vmcnt(0)" ::: "memory");
    __syncthreads();
    if (threadIdx.x == 0) {
        unsigned* bar = b.bar;
        __builtin_amdgcn_s_waitcnt(0);
        unsigned nloc = b.st[0], nx = b.st[1];
        if (nloc == 0u) { xcd_barrier_complete(bar, b.x, nloc, nx); b.st[0] = nloc; b.st[1] = nx; }
        const unsigned old = xb_add(&bar[XB_XSUB(b.x)], 1u);
        const unsigned gen = old / nloc;
        if (old + 1u == (gen + 1u) * nloc) {
            __builtin_amdgcn_fence(__ATOMIC_RELEASE, "agent");
            asm volatile("s_waitcnt vmcnt(0)" ::: "memory");
            const unsigned og = xb_add(&bar[XB_TOP], 1u);
            const unsigned tg = og / nx;
            if (og + 1u == (tg + 1u) * nx) xb_add(&bar[XB_TOPGEN], 1u);
            else XB_SPIN(xb_ld(&bar[XB_TOPGEN]) == tg, bar);
            __builtin_amdgcn_fence(__ATOMIC_ACQUIRE, "agent");
            xb_add(&bar[XB_XGEN(b.x)], 1u);
            asm volatile("s_waitcnt vmcnt(0)" ::: "memory");
        } else {
            XB_SPIN(xb_ld(&bar[XB_XGEN(b.x)]) == gen, bar);
            __builtin_amdgcn_fence(__ATOMIC_ACQUIRE, "agent");
            asm volatile("s_waitcnt vmcnt(0)" ::: "memory");
        }
    }
    __syncthreads();
}

struct EpiAny {
    static constexpr bool PERM = true;
    int kind; float* X; bf16_t* XB; rs2_t* rss; const rs2_t* rsin; bf16_t* O;
    __device__ __forceinline__ void operator()(AccRef acc, const pg8::Unit& u, int wr, int wc, int fr, int fq) const {
        if (kind == 0) { EpiGLU E; E.X = X; E.XB = XB; E.rss = rss; E(acc, u, wr, wc, fr, fq); }
        else if (kind == 1) { EpiSwiGLU E; E.H = O; E.rs2 = rsin; E(acc, u, wr, wc, fr, fq); }
        else if (kind == 2) { EpiResid E; E.X = X; E.XB = XB; E.rss = rss; E(acc, u, wr, wc, fr, fq); }
        else { EpiQKV E; E.O = O; E.rs2 = rsin; E(acc, u, wr, wc, fr, fq); }
    }
};

__global__ void __launch_bounds__(512, 2) mega(Params p_) {
    KP& p = *(KP*)__builtin_amdgcn_kernarg_segment_ptr();
    extern __shared__ __attribute__((aligned(16))) unsigned char shm[];
    cg::grid_group grid = cg::this_grid();
    volatile LAS unsigned* bst = (volatile LAS unsigned*)((LAS unsigned char*)shm + 131072 + 4096);
    if (threadIdx.x == 0) { bst[0] = 0u; bst[1] = 0u; }
    __syncthreads();
    const XcdBarrier xbar = xcd_barrier_post((unsigned*)(p.ws + WS_BAR), bst);
    if (p.ph_lo == 0) {
        const int gi = blockIdx.x * 512 + threadIdx.x;
        if (gi < 2 * 4096) {
            const float are = p.in[8][gi], aim = p.in[9][gi]; const float dtf = expf(p.in[10][gi >> 6]);
            const float mag = expf(are * dtf);
            const double rev = (double)aim * (double)dtf * 0.15915494309189535;
            const float ang = (float)((rev - rint(rev)) * 6.283185307179586);
            float sn, cs; sincosf(ang, &sn, &cs);
            const float lr = mag * cs, li = mag * sn;
            const float den = are * are + aim * aim, nr = lr - 1.0f, ni = li;
            f32x4 o; o[0] = lr; o[1] = li; o[2] = (nr * are + ni * aim) / den; o[3] = (ni * are - nr * aim) / den;
            ((f32x4*)(p.ws + WS_SSMC))[gi] = o;
        }
    }
    for (int ph = p.ph_lo; ph < p.ph_hi; ++ph) {
        if (ph > p.ph_lo) { if (p.ph_hi > 1000) grid.sync(); else xcd_barrier(xbar); }
        if (ph == 0) { if (PHM & 1) phase_prep(p, shm); continue; }
        const int q = ph - 1, pair = q / 9, rem = q % 9;
        const int layer = rem < 4 ? 2 * pair : 2 * pair + 1, kind = rem;
        const int j = layer >> 1;
        if (kind == 0) { if (PHM & 2) { phase_ssm2(p, layer, shm); if (REP_KIND == 0) { xcd_barrier(xbar); phase_ssm2(p, layer, shm); } } }
        else if (kind == 5) { if (PHM & 4) { phase_attn(p, layer, shm); if (REP_KIND == 5) { xcd_barrier(xbar); phase_attn(p, layer, shm); } } }
        else if (PHM & 8) {
            rs2_t* RS2 = (rs2_t*)(p.ws + WS_RS2);
            EpiAny E; E.X = (layer == 3 && kind == 8) ? p.out : nullptr; E.XB = (bf16_t*)(p.ws + WS_XB); E.O = nullptr;
            E.rss = RS2 + (size_t)((kind == 3 || kind == 8) ? 2 + 2 * layer : 1 + 2 * layer) * MT;
            E.rsin = RS2 + (size_t)((kind == 2 || kind == 7) ? 1 + 2 * layer : 2 * layer) * MT;
            pg8::Gemm g; g.M = MT;
            if (kind == 1) { E.kind = 0; g.A = (const bf16_t*)(p.ws + WS_Z); g.Bt = (const bf16_t*)(p.ws + WS_GLU + j * SZ_GLU); g.N = 2048; g.K = 1024; }
            else if (kind == 2 || kind == 7) { E.kind = 1; E.O = (bf16_t*)(p.ws + WS_H); g.A = E.XB; g.Bt = (const bf16_t*)(p.ws + WS_GU + layer * SZ_GU); g.N = 5632; g.K = 1024; }
            else if (kind == 3 || kind == 8) { E.kind = 2; g.A = (const bf16_t*)(p.ws + WS_H); g.Bt = (const bf16_t*)(p.ws + WS_DN + layer * SZ_DN); g.N = 1024; g.K = 2816; }
            else if (kind == 4) { E.kind = 3; E.O = (bf16_t*)(p.ws + WS_QKV); g.A = E.XB; g.Bt = (const bf16_t*)(p.ws + WS_QKVW + j * SZ_QKV); g.N = 1536; g.K = 1024; }
            else { E.kind = 2; g.A = (const bf16_t*)(p.ws + WS_Z); g.Bt = (const bf16_t*)(p.ws + WS_WO + j * SZ_WO); g.N = 1024; g.K = 1024; }
            const bool split = (E.kind == 0 || E.kind == 2);
            if (split) g.M = MP;
            pg8::StaticOrder S; S.init(g.M, g.N, (int)gridDim.x, (int)blockIdx.x);
            pg8::gemm_phase<EpiAny, pg8::StaticOrder>((LAS unsigned char*)shm, g, S, E);
            if (kind == 4) { const int G_ = (int)gridDim.x, nbusy = S.nwg - G_;
                if (nbusy >= 0 && nbusy < G_ && (int)blockIdx.x >= nbusy) cache_shift_copy(p, j, (int)blockIdx.x - nbusy, G_ - nbusy);
                else if (nbusy < 0 || nbusy >= G_) cache_shift_copy(p, j, (int)blockIdx.x, G_); }
            if (E.kind == 0) sgemm_tile<true>(g.A, g.Bt, g.K, E.X, E.XB, E.rss, (float*)shm);
            else if (E.kind == 2) sgemm_tile<false>(g.A, g.Bt, g.K, E.X, E.XB, E.rss, (float*)shm);
        }
    }
}

extern "C" void kernel_launch(void* const* d_in, const int* in_sizes, int n_in, void* d_out, int out_size, void* d_ws, size_t ws_size, hipStream_t stream) {
    static int grid = 0;
    if (grid == 0) {
        int dev = 0, cus = 0, per_cu = 0;
        hipGetDevice(&dev); hipDeviceGetAttribute(&cus, hipDeviceAttributeMultiprocessorCount, dev);
        if (hipFuncSetAttribute((const void*)mega, hipFuncAttributeMaxDynamicSharedMemorySize, LDS_BYTES) != hipSuccess) fprintf(stderr, "kernel_launch: hipFuncSetAttribute failed\n");
        if (hipOccupancyMaxActiveBlocksPerMultiprocessor(&per_cu, (const void*)mega, 512, LDS_BYTES) != hipSuccess || per_cu < 1) { fprintf(stderr, "kernel_launch: occupancy query gave %d\n", per_cu); per_cu = 1; }
        (void)hipGetLastError();
        if (cus <= 0) cus = 256;
        grid = cus * 1;
        if (ws_size < WS_END) fprintf(stderr, "kernel_launch: workspace too small: %zu < %zu\n", ws_size, (size_t)WS_END);
    }
    if (hipMemsetAsync((char*)d_ws + WS_BAR, 0, 3456 * 4, stream) != hipSuccess) fprintf(stderr, "kernel_launch: memset of the barrier words failed\n");
    Params p{};
    for (int i = 0; i < 24; ++i) p.in[i] = (const float*)d_in[i];
    p.out = (float*)d_out; p.ws = (unsigned char*)d_ws;
    const int NPH = 19;
#if SPLIT_LAUNCH
    for (int ph = 0; ph < NPH; ++ph) {
        p.ph_lo = ph; p.ph_hi = ph + 1;
        void* args[] = {&p};
        hipError_t e = hipLaunchCooperativeKernel((const void*)mega, dim3(grid), dim3(512), args, LDS_BYTES, stream);
        if (e != hipSuccess) { fprintf(stderr, "kernel_launch: cooperative launch (phase %d) failed: %s\n", ph, hipGetErrorString(e)); break; }
    }
#else
    p.ph_lo = 0; p.ph_hi = NPH;
    void* args[] = {&p};
    hipError_t e = hipLaunchCooperativeKernel((const void*)mega, dim3(grid), dim3(512), args, LDS_BYTES, stream);
    if (e != hipSuccess) fprintf(stderr, "kernel_launch: cooperative launch failed: %s (grid %d)\n", hipGetErrorString(e), grid);
#endif
}
```
